# Optimizing an MI355X kernel written in HIP

```python
import jax, jax.numpy as jnp
from jax import lax
import numpy as np

D_MODEL = 1024
BATCH = 32
SEQ = 256
DEPTH = 2
DEC_BATCH = 8
DEC_SEQ = 2048
PAST_LEN = 256

GRID_W = 64
N_MOD = 9
FFN_DIM = 2816
EPS = 1e-6
GLA_HEADS = 4
GLA_DK = 64
GLA_DV = 128
GLA_GATE_RANK = 16
GLA_TAU = 16.0
GLA_CHUNK = 64
FN_GROUPS = 4
FN_CH = 128
SWA_HEADS = 16
SWA_KV_HEADS = 4
SWA_GROUP = SWA_HEADS // SWA_KV_HEADS
SWA_HD = 64
WINDOW = 128
ATTN_BLOCK = 128
ROPE_BASE = 10000.0

GLA_QK = GLA_HEADS * GLA_DK
GLA_V = GLA_HEADS * GLA_DV
FN_W = FN_GROUPS * FN_CH
L0_SPLITS = (GLA_QK, 2 * GLA_QK, 2 * GLA_QK + GLA_V, 2 * GLA_QK + 2 * GLA_V,
             2 * GLA_QK + 2 * GLA_V + GLA_GATE_RANK, 2 * GLA_QK + 2 * GLA_V + 2 * GLA_GATE_RANK)
L0_IN_DIM = L0_SPLITS[-1] + FN_W
L0_MIX = GLA_V + FN_W
SWA_Q = SWA_HEADS * SWA_HD
SWA_KV = SWA_KV_HEADS * SWA_HD
L1_IN_DIM = SWA_Q + 2 * SWA_KV

kernel_name = "hybrid_diffusion_gla_fnet_swa_step"


def _rms(x, g):
    xf = x.astype(jnp.float32)
    y = xf * lax.rsqrt(jnp.mean(xf * xf, axis=-1, keepdims=True) + EPS)
    return (y * g.astype(jnp.float32)).astype(x.dtype)


def _modulation(cond, w, b):
    m = jax.nn.silu(cond) @ w + b
    return jnp.split(m[:, None, :], N_MOD, axis=-1)


def _ada_norm(x, g, shift, scale):
    return _rms(x, g) * (1 + scale) + shift


def _half_ffn(x, shift, scale, gate, g, w1, w3, w2):
    h = _ada_norm(x, g, shift, scale)
    f = (jax.nn.silu(h @ w1) * (h @ w3)) @ w2
    return x + 0.5 * gate * f


def _gla_chunked(q, k, v, log_a, s0):
    B, T, H, DK = q.shape
    DV = v.shape[-1]
    N = T // GLA_CHUNK
    f32 = jnp.float32
    q = q.astype(f32).reshape(B, N, GLA_CHUNK, H, DK)
    k = k.astype(f32).reshape(B, N, GLA_CHUNK, H, DK)
    v = v.astype(f32).reshape(B, N, GLA_CHUNK, H, DV)
    g = log_a.astype(f32).reshape(B, N, GLA_CHUNK, H, DK)
    b = jnp.cumsum(g, axis=2)
    b_last = b[:, :, -1:]
    q_dec = q * jnp.exp(b)
    k_inv = k * jnp.exp(-b)
    k_end = k * jnp.exp(b_last - b)
    mask = jnp.tril(jnp.ones((GLA_CHUNK, GLA_CHUNK), f32))
    attn = jnp.einsum('bnthk,bnshk->bnhts', q_dec, k_inv) * mask
    o_intra = jnp.einsum('bnhts,bnshv->bnthv', attn, v)
    delta = jnp.einsum('bnshk,bnshv->bnhkv', k_end, v)
    decay = jnp.exp(b_last[:, :, 0])

    def step(S, inp):
        d, dl = inp
        return d[..., None] * S + dl, S

    s_fin, s_in = lax.scan(step, s0.astype(f32), (jnp.moveaxis(decay, 1, 0), jnp.moveaxis(delta, 1, 0)))
    s_in = jnp.moveaxis(s_in, 0, 1)
    o_inter = jnp.einsum('bnthk,bnhkv->bnthv', q_dec, s_in)
    return (o_intra + o_inter).reshape(B, T, H, DV), s_fin


def _gla_fnet_mixer(h, s0_f, s0_b, w_in, w_gf, b_gf, w_gb, b_gb, g_head, w_out):
    B, T, _ = h.shape
    p = h @ w_in
    q, k, v, og, lf, lb, u = jnp.split(p, L0_SPLITS, axis=-1)
    q = q.reshape(B, T, GLA_HEADS, GLA_DK) * (GLA_DK ** -0.5)
    k = k.reshape(B, T, GLA_HEADS, GLA_DK)
    v = v.reshape(B, T, GLA_HEADS, GLA_DV)
    la_f = (jax.nn.log_sigmoid((lf @ w_gf + b_gf).astype(jnp.float32)) / GLA_TAU).reshape(B, T, GLA_HEADS, GLA_DK)
    la_b = (jax.nn.log_sigmoid((lb @ w_gb + b_gb).astype(jnp.float32)) / GLA_TAU).reshape(B, T, GLA_HEADS, GLA_DK)
    rev = lambda z: z[:, ::-1]
    o_f, s_f = _gla_chunked(q, k, v, la_f, s0_f)
    o_b, s_b = _gla_chunked(rev(q), rev(k), rev(v), rev(la_b), s0_b)
    o = _rms(o_f + rev(o_b), g_head)
    gla_out = (o * jax.nn.silu(og.reshape(B, T, GLA_HEADS, GLA_DV).astype(jnp.float32)))
    gla_out = gla_out.reshape(B, T, GLA_V).astype(h.dtype)
    uf = u.reshape(B, T, FN_GROUPS, FN_CH).astype(jnp.float32)
    fn_out = jnp.fft.fft2(uf, axes=(1, 3), norm='ortho').real.reshape(B, T, FN_W).astype(h.dtype)
    return jnp.concatenate([gla_out, fn_out], axis=-1) @ w_out, s_f, s_b


def _sink_attend(q, k, v, valid, sink):
    s = jnp.einsum('bqhgd,bkhd->bhgqk', q, k).astype(jnp.float32)
    if valid is not None:
        s = jnp.where(valid, s, -jnp.inf)
    sk = jnp.broadcast_to(sink.astype(jnp.float32)[None, :, :, None, None], s.shape[:-1] + (1,))
    p = jax.nn.softmax(jnp.concatenate([s, sk], axis=-1), axis=-1)[..., :-1]
    return jnp.einsum('bhgqk,bkhd->bqhgd', p.astype(v.dtype), v)


def _swa_project(h, w_in):
    B, T, _ = h.shape
    q, k, v = jnp.split(h @ w_in, (SWA_Q, SWA_Q + SWA_KV), axis=-1)
    q = q.reshape(B, T, SWA_KV_HEADS, SWA_GROUP, SWA_HD) * (SWA_HD ** -0.5)
    k = k.reshape(B, T, SWA_KV_HEADS, SWA_HD)
    v = v.reshape(B, T, SWA_KV_HEADS, SWA_HD)
    return q, k, v


def _axial_rope_tables(T):
    rows = T // GRID_W
    row = jnp.repeat(jnp.arange(rows), GRID_W).astype(jnp.float32)
    col = (jnp.arange(rows * GRID_W) % GRID_W).astype(jnp.float32)
    n_freq = SWA_HD // 4
    inv = ROPE_BASE ** (-jnp.arange(n_freq, dtype=jnp.float32) / n_freq)
    ar = row[:, None] * inv
    ac = col[:, None] * inv
    ang = jnp.concatenate([ar, ar, ac, ac], axis=-1)
    return jnp.cos(ang), jnp.sin(ang)


def _rope(x, cos, sin):
    T = x.shape[1]
    shp = (1, T) + (1,) * (x.ndim - 3) + (SWA_HD,)
    a, b, c2, d = jnp.split(x, 4, axis=-1)
    rot = jnp.concatenate([-b, a, -d, c2], axis=-1)
    return (x * cos.reshape(shp) + rot * sin.reshape(shp)).astype(x.dtype)


def _swa_context(h, w_in, sink, w_out):
    B, T, _ = h.shape
    q, k, v = _swa_project(h, w_in)
    nb = T // ATTN_BLOCK
    qb = jnp.moveaxis(q.reshape(B, nb, ATTN_BLOCK, SWA_KV_HEADS, SWA_GROUP, SWA_HD), 1, 0)
    o = lax.map(lambda qi: _sink_attend(qi, k, v, None, sink), qb)
    o = jnp.moveaxis(o, 0, 1).reshape(B, T, SWA_Q)
    return o @ w_out, k, v


def _swa_latent(h, ctx_k, ctx_v, w_in, sink, w_out):
    B, T, _ = h.shape
    q, k, v = _swa_project(h, w_in)
    cos, sin = _axial_rope_tables(T)
    q = _rope(q, cos, sin)
    k = _rope(k, cos, sin)
    Lc = ctx_k.shape[1]
    nb = T // ATTN_BLOCK
    pad = ((0, 0), (ATTN_BLOCK, ATTN_BLOCK), (0, 0), (0, 0))
    kp = jnp.pad(k, pad)
    vp = jnp.pad(v, pad)
    ctx_valid = jnp.ones((ATTN_BLOCK, Lc), bool)

    def block(i):
        qi = lax.dynamic_slice_in_dim(q, i * ATTN_BLOCK, ATTN_BLOCK, axis=1)
        ki = lax.dynamic_slice_in_dim(kp, i * ATTN_BLOCK, 3 * ATTN_BLOCK, axis=1)
        vi = lax.dynamic_slice_in_dim(vp, i * ATTN_BLOCK, 3 * ATTN_BLOCK, axis=1)
        qpos = i * ATTN_BLOCK + jnp.arange(ATTN_BLOCK)
        kpos = (i - 1) * ATTN_BLOCK + jnp.arange(3 * ATTN_BLOCK)
        band = (jnp.abs(qpos[:, None] - kpos[None, :]) <= WINDOW) & (kpos >= 0)[None, :] & (kpos < T)[None, :]
        valid = jnp.concatenate([ctx_valid, band], axis=1)
        return _sink_attend(qi, jnp.concatenate([ctx_k.astype(ki.dtype), ki], axis=1),
                            jnp.concatenate([ctx_v.astype(vi.dtype), vi], axis=1), valid, sink)

    o = lax.map(block, jnp.arange(nb))
    o = jnp.moveaxis(o, 0, 1).reshape(B, T, SWA_Q)
    return o @ w_out


def setup_inputs(seed: int = 0) -> dict:
    key = jax.random.key(seed)
    ks = jax.random.split(key, 32)
    D = D_MODEL
    n = lambda k, shape, s: jax.random.normal(k, shape, jnp.float32) * s
    return {
        "x_prompt": n(ks[0], (BATCH, SEQ, D), 1.0),
        "x_sample": n(ks[1], (DEC_BATCH, DEC_SEQ, D), 1.0),
        "state_l0_gla_fwd": n(ks[2], (DEC_BATCH, GLA_HEADS, GLA_DK, GLA_DV), 0.3),
        "state_l0_gla_bwd": n(ks[3], (DEC_BATCH, GLA_HEADS, GLA_DK, GLA_DV), 0.3),
        "cache_l1_k": n(ks[4], (DEC_BATCH, PAST_LEN, SWA_KV_HEADS, SWA_HD), 1.0),
        "cache_l1_v": n(ks[5], (DEC_BATCH, PAST_LEN, SWA_KV_HEADS, SWA_HD), 1.0),
        "c": n(ks[6], (DEC_BATCH, D), 1.0),
        "c_ctx": n(ks[7], (D,), 1.0),
        "mod_w": n(ks[8], (DEPTH, D, N_MOD * D), 0.5 * D ** -0.5),
        "mod_b": n(ks[9], (DEPTH, N_MOD * D), 0.02),
        "norm_g": 1.0 + n(ks[10], (DEPTH, 3, D), 0.05),
        "ffn_w1": n(ks[11], (DEPTH, 2, D, FFN_DIM), D ** -0.5),
        "ffn_w3": n(ks[12], (DEPTH, 2, D, FFN_DIM), D ** -0.5),
        "ffn_w2": n(ks[13], (DEPTH, 2, FFN_DIM, D), FFN_DIM ** -0.5),
        "l0_w_in": n(ks[14], (D, L0_IN_DIM), D ** -0.5),
        "l0_w_gf": n(ks[15], (GLA_GATE_RANK, GLA_QK), GLA_GATE_RANK ** -0.5),
        "l0_b_gf": n(ks[16], (GLA_QK,), 0.1),
        "l0_w_gb": n(ks[17], (GLA_GATE_RANK, GLA_QK), GLA_GATE_RANK ** -0.5),
        "l0_b_gb": n(ks[18], (GLA_QK,), 0.1),
        "l0_g_head": 1.0 + n(ks[19], (GLA_DV,), 0.05),
        "l0_w_out": n(ks[20], (L0_MIX, D), L0_MIX ** -0.5),
        "l1_w_in": n(ks[21], (D, L1_IN_DIM), D ** -0.5),
        "l1_sink": n(ks[22], (SWA_KV_HEADS, SWA_GROUP), 0.5),
        "l1_w_out": n(ks[23], (SWA_Q, D), SWA_Q ** -0.5),
        "final_g": 1.0 + n(ks[24], (D,), 0.05),
    }


def reference(x_prompt, x_sample, state_l0_gla_fwd, state_l0_gla_bwd, cache_l1_k, cache_l1_v, c, c_ctx,
              mod_w, mod_b, norm_g, ffn_w1, ffn_w3, ffn_w2,
              l0_w_in, l0_w_gf, l0_b_gf, l0_w_gb, l0_b_gb, l0_g_head, l0_w_out,
              l1_w_in, l1_sink, l1_w_out, final_g):
    xp, xs = x_prompt, x_sample
    new_state = []
    for layer in range(DEPTH):
        mp = _modulation(c_ctx[None, :], mod_w[layer], mod_b[layer])
        ms = _modulation(c, mod_w[layer], mod_b[layer])
        ffn_a = (norm_g[layer, 0], ffn_w1[layer, 0], ffn_w3[layer, 0], ffn_w2[layer, 0])
        ffn_b = (norm_g[layer, 2], ffn_w1[layer, 1], ffn_w3[layer, 1], ffn_w2[layer, 1])
        xp = _half_ffn(xp, mp[0], mp[1], mp[2], *ffn_a)
        xs = _half_ffn(xs, ms[0], ms[1], ms[2], *ffn_a)
        hp = _ada_norm(xp, norm_g[layer, 1], mp[3], mp[4])
        hs = _ada_norm(xs, norm_g[layer, 1], ms[3], ms[4])
        if layer % 2 == 0:
            w = (l0_w_in, l0_w_gf, l0_b_gf, l0_w_gb, l0_b_gb, l0_g_head, l0_w_out)
            zero = jnp.zeros((xp.shape[0], GLA_HEADS, GLA_DK, GLA_DV), jnp.float32)
            op, s_f, s_b = _gla_fnet_mixer(hp, zero, zero, *w)
            os_, _, _ = _gla_fnet_mixer(hs, state_l0_gla_fwd, state_l0_gla_bwd, *w)
            new_state += [s_f, s_b]
        else:
            op, k_c, v_c = _swa_context(hp, l1_w_in, l1_sink, l1_w_out)
            os_ = _swa_latent(hs, cache_l1_k, cache_l1_v, l1_w_in, l1_sink, l1_w_out)
            new_state += [k_c, v_c]
        xp = xp + mp[5] * op
        xs = xs + ms[5] * os_
        xp = _half_ffn(xp, mp[6], mp[7], mp[8], *ffn_b)
        xs = _half_ffn(xs, ms[6], ms[7], ms[8], *ffn_b)
    y_prompt = _rms(xp, final_g)
    y_sample = _rms(xs, final_g)
    return (y_prompt, y_sample, *new_state)
```

```cpp
#include <hip/hip_runtime.h>
#include <hip/hip_cooperative_groups.h>
#include <cstdio>
namespace cg = cooperative_groups;

#define LAS __attribute__((address_space(3)))
typedef unsigned short bf16_t;
typedef short bf16x8 __attribute__((ext_vector_type(8)));
typedef float f32x4 __attribute__((ext_vector_type(4)));
typedef float f32x2 __attribute__((ext_vector_type(2)));
typedef unsigned u32x4 __attribute__((ext_vector_type(4)));
typedef unsigned u32x2 __attribute__((ext_vector_type(2)));

constexpr int R_ALL = 24576, R_P = 8192, DM = 1024, FF = 2816;
constexpr int NTHR = 512;
#define DBG_DFT 1
constexpr int LDS_BYTES = 147456;
constexpr float EPS = 1e-6f;

constexpr size_t AL(size_t x) { return (x + 255) & ~(size_t)255; }
constexpr size_t WS_MOD   = 0;
constexpr size_t WS_BAR   = AL(WS_MOD + (size_t)2 * 9 * 9216 * 4);
constexpr size_t WS_ROPE  = AL(WS_BAR + (size_t)16384);
constexpr size_t WS_WUP   = AL(WS_ROPE + (size_t)2048 * 32 * 2 * 4);
constexpr size_t WS_WDN   = AL(WS_WUP + (size_t)4 * 5632 * 1024 * 2);
constexpr size_t WS_WL0IN = AL(WS_WDN + (size_t)4 * 1024 * 2816 * 2);
constexpr size_t WS_WL0Z  = AL(WS_WL0IN + (size_t)1792 * 1024 * 2);
constexpr size_t WS_WL0O  = AL(WS_WL0Z + (size_t)1024 * 1024 * 2);
constexpr size_t WS_WL1IN = AL(WS_WL0O + (size_t)1024 * 1024 * 2);
constexpr size_t WS_WL1O  = AL(WS_WL1IN + (size_t)1536 * 1024 * 2);
constexpr size_t WS_DMS   = AL(WS_WL1O + (size_t)1024 * 1024 * 2);
constexpr size_t WS_DMP   = AL(WS_DMS + (size_t)2048 * 4096 * 2);
constexpr size_t WS_CTXK  = AL(WS_DMP + (size_t)256 * 512 * 2);
constexpr size_t WS_CTXV  = AL(WS_CTXK + (size_t)2048 * 256 * 2);
constexpr size_t WS_H     = AL(WS_CTXV + (size_t)2048 * 256 * 2);
constexpr size_t WS_OB    = AL(WS_H + (size_t)R_ALL * 1024 * 2);
constexpr size_t WS_ACT   = AL(WS_OB + (size_t)R_ALL * 512 * 2);
constexpr size_t WS_END   = AL(WS_ACT + (size_t)R_ALL * 2816 * 2 + (size_t)262144);
constexpr size_t WS_P     = WS_ACT;
constexpr size_t WS_LG    = AL(WS_P + (size_t)R_ALL * 1536 * 2);
constexpr size_t WS_ZTS   = AL(WS_LG + (size_t)R_ALL * 32 * 4);
constexpr size_t WS_ZTP   = AL(WS_ZTS + (size_t)8 * 512 * 4096 * 2);
static_assert(WS_ZTP + (size_t)32 * 512 * 512 * 2 <= WS_END, "overlay");
constexpr size_t WS_Q     = WS_ACT;
constexpr size_t WS_K     = AL(WS_Q + (size_t)R_ALL * 1024 * 2);
constexpr size_t WS_V     = AL(WS_K + (size_t)R_ALL * 256 * 2);

constexpr size_t OUT_SF = (size_t)R_ALL * 1024, OUT_SB = OUT_SF + 1048576, OUT_KC = OUT_SB + 1048576, OUT_VC = OUT_KC + 2097152;

struct Params {
    const float* x_prompt; const float* x_sample; const float* st_f; const float* st_b; const float* cache_k; const float* cache_v;
    const float* c; const float* c_ctx; const float* mod_w; const float* mod_b; const float* norm_g;
    const float* ffn_w1; const float* ffn_w3; const float* ffn_w2;
    const float* l0_w_in; const float* l0_w_gf; const float* l0_b_gf; const float* l0_w_gb; const float* l0_b_gb; const float* l0_g_head; const float* l0_w_out;
    const float* l1_w_in; const float* l1_sink; const float* l1_w_out; const float* final_g;
    float* out; unsigned char* ws;
    int ph_lo, ph_hi, coop, pad;
};

typedef __bf16 bf16x2_t __attribute__((ext_vector_type(2)));
__device__ __forceinline__ unsigned cvt_pk_bf16(float lo, float hi) { const f32x2 v = (f32x2){lo, hi}; return __builtin_bit_cast(unsigned, __builtin_convertvector(v, bf16x2_t)); }
__device__ __forceinline__ bf16_t f2bf(float f) { return (bf16_t)(cvt_pk_bf16(f, 0.f) & 0xffffu); }
__device__ __forceinline__ float bf2f(bf16_t b) { return __uint_as_float(((unsigned)b) << 16); }
__device__ __forceinline__ float bflo(unsigned w) { return __uint_as_float(w << 16); }
__device__ __forceinline__ float bfhi(unsigned w) { return __uint_as_float(w & 0xffff0000u); }
__device__ __forceinline__ float siluf(float a) { return a * __builtin_amdgcn_rcpf(1.0f + __expf(-a)); }
__device__ __forceinline__ float max_x16_x32(float v) {
    u32x2 a = __builtin_amdgcn_permlane16_swap(__float_as_uint(v), __float_as_uint(v), false, false); v = fmaxf(__uint_as_float(a.x), __uint_as_float(a.y));
    u32x2 b = __builtin_amdgcn_permlane32_swap(__float_as_uint(v), __float_as_uint(v), false, false); return fmaxf(__uint_as_float(b.x), __uint_as_float(b.y));
}
__device__ __forceinline__ float sum_x16_x32(float v) {
    u32x2 a = __builtin_amdgcn_permlane16_swap(__float_as_uint(v), __float_as_uint(v), false, false); v = __uint_as_float(a.x) + __uint_as_float(a.y);
    u32x2 b = __builtin_amdgcn_permlane32_swap(__float_as_uint(v), __float_as_uint(v), false, false); return __uint_as_float(b.x) + __uint_as_float(b.y);
}
__device__ __forceinline__ int mod_index(int row) { return row < R_P ? 0 : 1 + ((row - R_P) >> 11); }


#define XB_TMO      128
#define XB_XCNT(j)  (256  + 64 * (j))
#define XB_XSUB(j)  (1280 + 64 * (j))
#define XB_XGEN(j)  (2304 + 64 * (j))
#define XB_TOP      3328
#define XB_TOPGEN   3392
#define XCD_BAR_WORDS 3456
#define XB_SPIN_CAP (1u << 20)
__device__ __forceinline__ unsigned xb_ld(unsigned* p)              { return __hip_atomic_load(p, __ATOMIC_RELAXED, __HIP_MEMORY_SCOPE_AGENT); }
__device__ __forceinline__ unsigned xb_add(unsigned* p, unsigned v) { return __hip_atomic_fetch_add(p, v, __ATOMIC_RELAXED, __HIP_MEMORY_SCOPE_AGENT); }
__device__ __forceinline__ unsigned xb_xcc_id() { return (unsigned)__builtin_amdgcn_s_getreg((3 << 11) | 20) & 0xFu; }
#define XB_SPIN(cond, bar) do { unsigned _sp = 0; while (cond) { __builtin_amdgcn_s_sleep(1); \
    if ((++_sp & 255u) == 0u) { if (xb_ld(&(bar)[XB_TMO])) break; if (_sp > XB_SPIN_CAP) { atomicAdd(&(bar)[XB_TMO], 1u); break; } } } } while (0)
struct XcdBarrier { unsigned* bar; unsigned x; volatile LAS unsigned* st; };
__device__ __forceinline__ XcdBarrier xcd_barrier_post(unsigned* bar, volatile LAS unsigned* st) {
    XcdBarrier b; b.bar = bar; b.x = xb_xcc_id(); b.st = st;
    if (threadIdx.x == 0) (void)xb_add(&bar[XB_XCNT(b.x)], 1u);
    return b;
}
__device__ __forceinline__ void xcd_barrier_complete(unsigned* bar, unsigned x, unsigned& nloc, unsigned& nx) {
    const unsigned G = gridDim.x * gridDim.y * gridDim.z;
    unsigned sum, cnt, mine, sp = 0u;
    for (;;) {
        sum = 0u; cnt = 0u; mine = 0u;
#pragma unroll
        for (unsigned j = 0; j < 16; ++j) { const unsigned c = xb_ld(&bar[XB_XCNT(j)]); sum += c; cnt += (c > 0u) ? 1u : 0u; mine = (j == x) ? c : mine; }
        if (sum == G) break;
        __builtin_amdgcn_s_sleep(1);
        if ((++sp & 255u) == 0u) { if (xb_ld(&bar[XB_TMO])) break; if (sp > XB_SPIN_CAP) { atomicAdd(&bar[XB_TMO], 1u); break; } }
    }
    nloc = mine > 0u ? mine : 1u; nx = cnt > 0u ? cnt : 1u;
}
__device__ __forceinline__ void xcd_barrier(const XcdBarrier& b) {
    asm volatile("s_waitcnt vmcnt(0)" ::: "memory");
    __syncthreads();
    if (threadIdx.x == 0) {
        unsigned* bar = b.bar;
        __builtin_amdgcn_s_waitcnt(0);
        unsigned nloc = b.st[0], nx = b.st[1];
        if (nloc == 0u) { xcd_barrier_complete(bar, b.x, nloc, nx); b.st[0] = nloc; b.st[1] = nx; }
        const unsigned old = xb_add(&bar[XB_XSUB(b.x)], 1u);
        const unsigned gen = old / nloc;
        if (old + 1u == (gen + 1u) * nloc) {
            __builtin_amdgcn_fence(__ATOMIC_RELEASE, "agent");
            asm volatile("s_waitcnt vmcnt(0)" ::: "memory");
            const unsigned og = xb_add(&bar[XB_TOP], 1u);
            const unsigned tg = og / nx;
            if (og + 1u == (tg + 1u) * nx) xb_add(&bar[XB_TOPGEN], 1u);
            else XB_SPIN(xb_ld(&bar[XB_TOPGEN]) == tg, bar);
            __builtin_amdgcn_fence(__ATOMIC_ACQUIRE, "agent");
            xb_add(&bar[XB_XGEN(b.x)], 1u);
            asm volatile("s_waitcnt vmcnt(0)" ::: "memory");
        } else {
            XB_SPIN(xb_ld(&bar[XB_XGEN(b.x)]) == gen, bar);
            __builtin_amdgcn_fence(__ATOMIC_ACQUIRE, "agent");
            asm volatile("s_waitcnt vmcnt(0)" ::: "memory");
        }
    }
    __syncthreads();
}

namespace pg8 {
constexpr int BM = 256, BK = 64, HALF = 128, HTB = HALF * BK * 2, NXCD = 8, WGM = 4;
__device__ __forceinline__ int lds_byte(int r, int c) { const int st = (r >> 4) * 2 + (c >> 5), rr = r & 15, cc = c & 31, ob = rr * 64 + cc * 2; return st * 1024 + (ob ^ (((ob >> 9) & 1) << 5)); }
__device__ __forceinline__ void stage_rc(int b, int& R, int& C) { const int st = b / 1024, sb = b % 1024, swz = sb ^ (((sb >> 9) & 1) << 5); R = (st >> 1) * 16 + swz / 64; C = (st & 1) * 32 + (swz % 64) / 2; }
__device__ __forceinline__ int perm32(int rho) { const int n = rho >> 4, i = rho & 15; return 8 * (i >> 2) + 4 * n + (i & 3); }

struct Unit { const char* a; const char* b; int pm, pn; };

struct GridSrc {
    const char* A; const char* B; size_t tstepA, tstepB; int nM, nN, nwg, G, c;
    __device__ void init(const void* A_, int lda, const void* B_, int ldb, int M, int N, int G_, int c_, int bm = BM) {
        A = (const char*)A_; B = (const char*)B_; tstepA = (size_t)bm * lda * 2; tstepB = (size_t)BM * ldb * 2; nM = M / bm; nN = N / BM; nwg = nM * nN; G = G_; c = c_; }
    __device__ bool next(int i, Unit& u) const {
        const long L = (long)i * G + c; if (L >= nwg) return false;
        int wgid = (int)L; { const int q = nwg / NXCD, r = nwg % NXCD, xcd = wgid % NXCD, off = wgid / NXCD; wgid = (xcd < r ? xcd * (q + 1) : r * (q + 1) + (xcd - r) * q) + off; }
        const int nig = WGM * nN, gid = wgid / nig, fm = gid * WGM, gsz = (nM - fm) < WGM ? (nM - fm) : WGM;
        u.pm = fm + ((wgid % nig) % gsz); u.pn = (wgid % nig) / gsz;
        u.a = A + (size_t)u.pm * tstepA; u.b = B + (size_t)u.pn * tstepB; return true;
    }
};
struct OneSrc {
    Unit u0;
    __device__ bool next(int i, Unit& u) const { if (i != 0) return false; u = u0; return true; }
};

template <class Epi, class Src>
__device__ __forceinline__ void gemm_phase(LAS unsigned char* lds, const int lda, const int ldb, const int K, const Src& S, const Epi& E, const size_t kstepA = 128, const size_t kstepB = 128) {
    const int tid = threadIdx.x, wid = __builtin_amdgcn_readfirstlane(tid >> 6), lane = tid & 63, wr = wid >> 2, wc = wid & 3, fr = lane & 15, fq = lane >> 4;
    constexpr int MT = Epi::MT;
    const int nt = K / BK;
    unsigned voffA[2], voffB[2];
#pragma unroll
    for (int i = 0; i < 2; ++i) { int R, C; stage_rc(tid * 16 + i * 8192, R, C); const int Rb = Epi::PERM ? ((R & ~31) + perm32(R & 31)) : R;
        voffA[i] = (unsigned)(R * lda + C) * 2u; voffB[i] = (unsigned)(Rb * ldb + C) * 2u; }
    const size_t hstepA = (size_t)(MT * 32) * lda * 2, hstepB = (size_t)HALF * ldb * 2;
    const unsigned ldsw = (unsigned)wid * 1024u;
    const int aoff = lds_byte(wr * (MT * 16) + fr, fq * 8), boff = lds_byte(wc * 32 + fr, fq * 8);
#define PG8_SA(b, h) (((b) * 2 + (h)) * HTB)
#define PG8_SB(b, h) ((4 + (b) * 2 + (h)) * HTB)
#define PG8_STAGE(bufoff, gbase, voff) do { _Pragma("unroll") for (int _i = 0; _i < 2; ++_i) \
        __builtin_amdgcn_global_load_lds((const unsigned*)((const char*)(gbase) + (voff)[_i]), (LAS unsigned*)(lds + (bufoff) + ldsw + _i * 8192), 16, 0, 0); } while (0)
#define PG8_STAGE_A(bufoff, gbase) do { __builtin_amdgcn_global_load_lds((const unsigned*)((const char*)(gbase) + voffA[0]), (LAS unsigned*)(lds + (bufoff) + ldsw), 16, 0, 0); \
        if (MT == 4 || wr == 0) __builtin_amdgcn_global_load_lds((const unsigned*)((const char*)(gbase) + voffA[1]), (LAS unsigned*)(lds + (bufoff) + ldsw + 8192), 16, 0, 0); } while (0)
#define PG8_LDA(dst, b, h) do { _Pragma("unroll") for (int m = 0; m < MT; ++m) _Pragma("unroll") for (int k = 0; k < 2; ++k) dst[m][k] = *(const LAS bf16x8*)(lds + PG8_SA(b, h) + aoff + m * 2048 + k * 1024); } while (0)
#define PG8_LDB(dst, b, h) do { _Pragma("unroll") for (int n = 0; n < 2; ++n) _Pragma("unroll") for (int k = 0; k < 2; ++k) dst[n][k] = *(const LAS bf16x8*)(lds + PG8_SB(b, h) + boff + n * 2048 + k * 1024); } while (0)
#define PG8_MMA(ai, bj, At, Bt) do { __builtin_amdgcn_s_setprio(1); _Pragma("unroll") for (int m = 0; m < MT; ++m) _Pragma("unroll") for (int n = 0; n < 2; ++n) _Pragma("unroll") for (int k = 0; k < 2; ++k) \
        acc[ai][bj][m][n] = __builtin_amdgcn_mfma_f32_16x16x32_bf16(Bt[n][k], At[m][k], acc[ai][bj][m][n], 0, 0, 0); __builtin_amdgcn_s_setprio(0); } while (0)
#define PG8_WAIT_V(n) asm volatile("s_waitcnt vmcnt(" #n ")" ::: "memory")
#define PG8_WAIT_L(n) asm volatile("s_waitcnt lgkmcnt(" #n ")" ::: "memory")
#define PG8_BAR __builtin_amdgcn_s_barrier()
#define PG8_SCHED __builtin_amdgcn_sched_barrier(0)
    Unit cur, nxt; int ui = 0;
    if (!S.next(0, cur)) return;
    f32x4 acc[2][2][MT][2];
#pragma unroll
    for (int a = 0; a < 2; ++a)
#pragma unroll
        for (int b = 0; b < 2; ++b)
#pragma unroll
            for (int m = 0; m < MT; ++m)
#pragma unroll
                for (int n = 0; n < 2; ++n) acc[a][b][m][n] = (f32x4){0.f, 0.f, 0.f, 0.f};
    bf16x8 At[MT][2], B0[2][2], B1[2][2];
    const char* cA = cur.a; const char* cB = cur.b;
    PG8_STAGE(PG8_SB(0, 0), cB, voffB); PG8_STAGE_A(PG8_SA(0, 0), cA); PG8_STAGE(PG8_SB(0, 1), cB + hstepB, voffB); PG8_STAGE_A(PG8_SA(0, 1), cA + hstepA);
    if (wr == 1) PG8_BAR;
    if (MT == 3 && wr == 1) PG8_WAIT_V(3); else PG8_WAIT_V(4);
    PG8_BAR;
    PG8_STAGE(PG8_SB(1, 0), cB + kstepB, voffB); PG8_STAGE_A(PG8_SA(1, 0), cA + kstepA); PG8_STAGE(PG8_SB(1, 1), cB + hstepB + kstepB, voffB);
    if (MT == 3 && wr == 1) PG8_WAIT_V(5); else PG8_WAIT_V(6);
    PG8_BAR;
    for (;;) {
        const bool has_next = S.next(ui + 1, nxt);
        const char* nA = has_next ? nxt.a : cA; const char* nB = has_next ? nxt.b : cB;
        for (int t = 0; t < nt; t += 2) {
            const bool last = (t == nt - 2);
            const char* a1 = cA + (size_t)(t + 1) * kstepA;
            const char* a2 = last ? nA : cA + (size_t)(t + 2) * kstepA; const char* b2 = last ? nB : cB + (size_t)(t + 2) * kstepB;
            const char* a3 = a2 + kstepA; const char* b3 = b2 + kstepB;
            PG8_LDB(B0, 0, 0); PG8_SCHED; PG8_LDA(At, 0, 0); PG8_STAGE_A(PG8_SA(1, 1), a1 + hstepA);
            PG8_WAIT_L(8); PG8_BAR; PG8_WAIT_L(0); PG8_MMA(0, 0, At, B0); PG8_BAR; PG8_SCHED;
            PG8_LDB(B1, 0, 1); PG8_STAGE(PG8_SB(0, 0), b2, voffB);
            PG8_BAR; PG8_WAIT_L(0); PG8_MMA(0, 1, At, B1); PG8_BAR;
            PG8_LDA(At, 0, 1); PG8_STAGE_A(PG8_SA(0, 0), a2);
            PG8_BAR; PG8_WAIT_L(0); PG8_MMA(1, 0, At, B0); PG8_BAR; PG8_SCHED;
            PG8_STAGE(PG8_SB(0, 1), b2 + hstepB, voffB);
            if (MT == 3 && wr == 1) PG8_WAIT_V(5); else PG8_WAIT_V(6);
            PG8_BAR; PG8_MMA(1, 1, At, B1); PG8_BAR;
            PG8_LDB(B0, 1, 0); PG8_SCHED; PG8_LDA(At, 1, 0); PG8_STAGE_A(PG8_SA(0, 1), a2 + hstepA);
            PG8_WAIT_L(8); PG8_BAR; PG8_WAIT_L(0); PG8_MMA(0, 0, At, B0); PG8_BAR; PG8_SCHED;
            PG8_LDB(B1, 1, 1); PG8_STAGE(PG8_SB(1, 0), b3, voffB);
            PG8_BAR; PG8_WAIT_L(0); PG8_MMA(0, 1, At, B1); PG8_BAR;
            PG8_LDA(At, 1, 1); PG8_STAGE_A(PG8_SA(1, 0), a3);
            PG8_BAR; PG8_WAIT_L(0); PG8_MMA(1, 0, At, B0); PG8_BAR; PG8_SCHED;
            PG8_STAGE(PG8_SB(1, 1), b3 + hstepB, voffB);
            if (MT == 3 && wr == 1) PG8_WAIT_V(5); else PG8_WAIT_V(6);
            PG8_BAR; PG8_MMA(1, 1, At, B1); PG8_BAR;
        }
        E(acc, cur, wr, wc, fr, fq);
        if (!has_next) break;
#pragma unroll
        for (int a = 0; a < 2; ++a)
#pragma unroll
            for (int b = 0; b < 2; ++b)
#pragma unroll
                for (int m = 0; m < MT; ++m)
#pragma unroll
                    for (int n = 0; n < 2; ++n) acc[a][b][m][n] = (f32x4){0.f, 0.f, 0.f, 0.f};
        cur = nxt; cA = nA; cB = nB; ++ui;
    }
    PG8_WAIT_V(0);
    if (wr == 0) PG8_BAR;
    PG8_BAR;
#undef PG8_SA
#undef PG8_SB
#undef PG8_STAGE
#undef PG8_STAGE_A
#undef PG8_LDA
#undef PG8_LDB
#undef PG8_MMA
#undef PG8_WAIT_V
#undef PG8_WAIT_L
#undef PG8_BAR
#undef PG8_SCHED
}
}
using pg8::Unit;

struct EpiUp {
    static constexpr int MT = 3;
    static constexpr bool PERM = true;
    bf16_t* act;
    __device__ __forceinline__ void operator()(const f32x4 (&acc)[2][2][MT][2], const Unit& u, int wr, int wc, int fr, int fq) const {
        const int row0 = u.pm * (MT * 64) + wr * (MT * 16) + fr, col0 = u.pn * 128 + wc * 32 + 8 * fq;
#pragma unroll
        for (int ai = 0; ai < 2; ++ai)
#pragma unroll
            for (int m = 0; m < MT; ++m) {
                float o[8];
#pragma unroll
                for (int n = 0; n < 2; ++n)
#pragma unroll
                    for (int j = 0; j < 4; ++j) o[n * 4 + j] = siluf(acc[ai][0][m][n][j]) * acc[ai][1][m][n][j];
                u32x4 w; w.x = cvt_pk_bf16(o[0], o[1]); w.y = cvt_pk_bf16(o[2], o[3]); w.z = cvt_pk_bf16(o[4], o[5]); w.w = cvt_pk_bf16(o[6], o[7]);
                *(u32x4*)(act + ((size_t)(u.pn * 2 + (wc >> 1)) * R_ALL + (row0 + ai * (MT * 32) + m * 16)) * 64 + (wc & 1) * 32 + 8 * fq) = w;
            }
    }
};
struct EpiRes {
    static constexpr int MT = 3;
    static constexpr bool PERM = false;
    float* X; const float* xin_p; const float* xin_s; const float* modl; int gchunk; float gs;
    __device__ __forceinline__ void operator()(const f32x4 (&acc)[2][2][MT][2], const Unit& u, int wr, int wc, int fr, int fq) const {
        const int row0 = u.pm * (MT * 64) + wr * (MT * 16) + fr, col0 = u.pn * 256 + wc * 32 + 4 * fq;
        f32x4 rv[2][MT][2][2];
#pragma unroll
        for (int ai = 0; ai < 2; ++ai)
#pragma unroll
            for (int m = 0; m < MT; ++m) { const int row = row0 + ai * (MT * 32) + m * 16;
                const float* rp = (xin_p ? (row < R_P ? xin_p + (size_t)row * DM : xin_s + (size_t)(row - R_P) * DM) : X + (size_t)row * DM) + col0;
#pragma unroll
                for (int bj = 0; bj < 2; ++bj)
#pragma unroll
                    for (int n = 0; n < 2; ++n) rv[ai][m][bj][n] = *(const f32x4*)(rp + bj * 128 + n * 16); }
        const int mi0 = mod_index(u.pm * (MT * 64)), mi1 = mod_index(u.pm * (MT * 64) + MT * 64 - 1);
        if (mi0 == mi1) {
            const float* gate = modl + (size_t)mi0 * 9216 + gchunk * 1024 + col0;
            f32x4 gv[2][2];
#pragma unroll
            for (int bj = 0; bj < 2; ++bj)
#pragma unroll
                for (int n = 0; n < 2; ++n) gv[bj][n] = *(const f32x4*)(gate + bj * 128 + n * 16) * gs;
#pragma unroll
            for (int ai = 0; ai < 2; ++ai)
#pragma unroll
                for (int m = 0; m < MT; ++m) { float* xp = X + (size_t)(row0 + ai * (MT * 32) + m * 16) * DM + col0;
#pragma unroll
                    for (int bj = 0; bj < 2; ++bj)
#pragma unroll
                        for (int n = 0; n < 2; ++n) *(f32x4*)(xp + bj * 128 + n * 16) = rv[ai][m][bj][n] + gv[bj][n] * acc[ai][bj][m][n]; }
        } else {
#pragma unroll
            for (int ai = 0; ai < 2; ++ai)
#pragma unroll
                for (int m = 0; m < MT; ++m) { const int row = row0 + ai * (MT * 32) + m * 16;
                    const float* gate = modl + (size_t)mod_index(row) * 9216 + gchunk * 1024 + col0; float* xp = X + (size_t)row * DM + col0;
#pragma unroll
                    for (int bj = 0; bj < 2; ++bj)
#pragma unroll
                        for (int n = 0; n < 2; ++n) { const f32x4 gv = *(const f32x4*)(gate + bj * 128 + n * 16);
                            *(f32x4*)(xp + bj * 128 + n * 16) = rv[ai][m][bj][n] + (gv * gs) * acc[ai][bj][m][n]; }
                    asm volatile("" ::: "memory"); }
        }
    }
};
struct EpiL0In {
    static constexpr int MT = 3;
    static constexpr bool PERM = false;
    bf16_t* P; float* LG;
    __device__ __forceinline__ void operator()(const f32x4 (&acc)[2][2][MT][2], const Unit& u, int wr, int wc, int fr, int fq) const {
        const int row0 = u.pm * (MT * 64) + wr * (MT * 16) + fr;
        if (u.pn < 6) {
            const int col0 = u.pn * 256 + wc * 32 + 4 * fq;
#pragma unroll
            for (int ai = 0; ai < 2; ++ai)
#pragma unroll
                for (int m = 0; m < MT; ++m) { bf16_t* pp = P + (size_t)(row0 + ai * (MT * 32) + m * 16) * 1536 + col0;
#pragma unroll
                    for (int bj = 0; bj < 2; ++bj)
#pragma unroll
                        for (int n = 0; n < 2; ++n) { const f32x4 v = acc[ai][bj][m][n]; u32x2 w; w.x = cvt_pk_bf16(v[0], v[1]); w.y = cvt_pk_bf16(v[2], v[3]); *(u32x2*)(pp + bj * 128 + n * 16) = w; } }
        } else if (wc == 0) {
#pragma unroll
            for (int ai = 0; ai < 2; ++ai)
#pragma unroll
                for (int m = 0; m < MT; ++m) { float* lp = LG + (size_t)(row0 + ai * (MT * 32) + m * 16) * 32 + 4 * fq;
#pragma unroll
                    for (int n = 0; n < 2; ++n) *(f32x4*)(lp + n * 16) = acc[ai][0][m][n]; }
        }
    }
};
struct EpiL0Z {
    static constexpr int MT = 4;
    static constexpr bool PERM = false;
    bf16_t* ZTS; bf16_t* ZTP;
    __device__ __forceinline__ void operator()(const f32x4 (&acc)[2][2][4][2], const Unit& u, int wr, int wc, int fr, int fq) const {
        const int part = u.pm >> 1, c0 = (u.pm & 1) * 256 + wr * 64 + fr;
        bf16_t* base; int ld;
        if (u.pn < 32) { base = ZTP + (size_t)u.pn * 512 * 512 + part * 256; ld = 512; }
        else { const int s = u.pn - 32; base = ZTS + (size_t)(s >> 3) * 512 * 4096 + part * 2048 + (s & 7) * 256; ld = 4096; }
        const int t0 = wc * 32 + 4 * fq;
#pragma unroll
        for (int ai = 0; ai < 2; ++ai)
#pragma unroll
            for (int m = 0; m < 4; ++m) { bf16_t* pp = base + (size_t)(c0 + ai * 128 + m * 16) * ld + t0;
#pragma unroll
                for (int bj = 0; bj < 2; ++bj)
#pragma unroll
                    for (int n = 0; n < 2; ++n) { const f32x4 v = acc[ai][bj][m][n]; u32x2 w; w.x = cvt_pk_bf16(v[0], v[1]); w.y = cvt_pk_bf16(v[2], v[3]); *(u32x2*)(pp + bj * 128 + n * 16) = w; } }
    }
};
struct EpiBf {
    static constexpr int MT = 4;
    static constexpr bool PERM = true;
    bf16_t* O; int ldc;
    __device__ __forceinline__ void operator()(const f32x4 (&acc)[2][2][4][2], const Unit& u, int wr, int wc, int fr, int fq) const {
        const int row0 = u.pm * 256 + wr * 64 + fr, col0 = u.pn * 256 + wc * 32 + 8 * fq;
#pragma unroll
        for (int ai = 0; ai < 2; ++ai)
#pragma unroll
            for (int m = 0; m < 4; ++m) { bf16_t* pp = O + (size_t)(row0 + ai * 128 + m * 16) * ldc + col0;
#pragma unroll
                for (int bj = 0; bj < 2; ++bj) { const f32x4 v0 = acc[ai][bj][m][0], v1 = acc[ai][bj][m][1];
                    u32x4 w; w.x = cvt_pk_bf16(v0[0], v0[1]); w.y = cvt_pk_bf16(v0[2], v0[3]); w.z = cvt_pk_bf16(v1[0], v1[1]); w.w = cvt_pk_bf16(v1[2], v1[3]);
                    *(u32x4*)(pp + bj * 128) = w; } }
    }
};
struct EpiQKV {
    static constexpr int MT = 3;
    static constexpr bool PERM = false;
    bf16_t* Q; bf16_t* Kb; bf16_t* Vb; float* kc; float* vc; const float* rope;
    __device__ __forceinline__ void operator()(const f32x4 (&acc)[2][2][MT][2], const Unit& u, int wr, int wc, int fr, int fq) const {
        const int row0 = u.pm * (MT * 64) + wr * (MT * 16) + fr;
        const float sc = u.pn < 4 ? 0.125f * 1.44269504089f : 1.0f;
#pragma unroll
        for (int ai = 0; ai < 2; ++ai)
#pragma unroll
            for (int m = 0; m < MT; ++m) {
                const int row = row0 + ai * (MT * 32) + m * 16; const bool samp = row >= R_P;
                f32x4 cs0 = (f32x4){1.f, 0.f, 1.f, 0.f}, cs1 = cs0;
                if (samp && u.pn < 5) { const int t = (row - R_P) & 2047; const float* rp = rope + ((size_t)t * 32 + (wc & 1) * 16 + 4 * fq) * 2; cs0 = *(const f32x4*)rp; cs1 = *(const f32x4*)(rp + 4); }
                const float cj[4] = {cs0[0], cs0[2], cs1[0], cs1[2]}, sj[4] = {cs0[1], cs0[3], cs1[1], cs1[3]};
#pragma unroll
                for (int bj = 0; bj < 2; ++bj) {
                    f32x4 v0 = acc[ai][bj][m][0] * sc, v1 = acc[ai][bj][m][1] * sc, o0, o1;
#pragma unroll
                    for (int j = 0; j < 4; ++j) { o0[j] = v0[j] * cj[j] - v1[j] * sj[j]; o1[j] = v1[j] * cj[j] + v0[j] * sj[j]; }
                    const int cl = bj * 128 + wc * 32 + 4 * fq;
                    u32x2 w0, w1; w0.x = cvt_pk_bf16(o0[0], o0[1]); w0.y = cvt_pk_bf16(o0[2], o0[3]); w1.x = cvt_pk_bf16(o1[0], o1[1]); w1.y = cvt_pk_bf16(o1[2], o1[3]);
                    if (u.pn < 4) { bf16_t* p = Q + (size_t)row * 1024 + u.pn * 256 + cl; *(u32x2*)p = w0; *(u32x2*)(p + 16) = w1; }
                    else if (u.pn == 4) { bf16_t* p = Kb + (size_t)row * 256 + cl; *(u32x2*)p = w0; *(u32x2*)(p + 16) = w1;
                        if (!samp) { float* f = kc + (size_t)row * 256 + cl; *(f32x4*)f = o0; *(f32x4*)(f + 16) = o1; } }
                    else { bf16_t* p = Vb + (size_t)row * 256 + cl; *(u32x2*)p = w0; *(u32x2*)(p + 16) = w1;
                        if (!samp) { float* f = vc + (size_t)row * 256 + cl; *(f32x4*)f = o0; *(f32x4*)(f + 16) = o1; } }
                }
            }
    }
};

__device__ __forceinline__ void transpose_tile(LAS float* tl, const float* src, int sld, int scol0, int k0, bf16_t* dst, int nrows, int drow0, int nvalid) {
    const int tid = threadIdx.x;
    { const int c4 = (tid & 15) * 4, kk = tid >> 4; f32x4 v[8];
#pragma unroll
      for (int h = 0; h < 8; ++h) { v[h] = (f32x4){0.f, 0.f, 0.f, 0.f}; if (c4 < nvalid) v[h] = __builtin_nontemporal_load((const f32x4*)(src + (size_t)(k0 + kk + h * 32) * sld + scol0 + c4)); }
#pragma unroll
      for (int h = 0; h < 8; ++h) { const int k = kk + h * 32; tl[k * 65 + c4] = v[h][0]; tl[k * 65 + c4 + 1] = v[h][1]; tl[k * 65 + c4 + 2] = v[h][2]; tl[k * 65 + c4 + 3] = v[h][3]; } }
    __syncthreads();
    { const int c = tid >> 3, kc = (tid & 7) * 8;
#pragma unroll
      for (int h = 0; h < 4; ++h) { float v[8];
#pragma unroll
          for (int e = 0; e < 8; ++e) v[e] = tl[(h * 64 + kc + e) * 65 + c];
          u32x4 w; w.x = cvt_pk_bf16(v[0], v[1]); w.y = cvt_pk_bf16(v[2], v[3]); w.z = cvt_pk_bf16(v[4], v[5]); w.w = cvt_pk_bf16(v[6], v[7]);
          *(u32x4*)(dst + ((size_t)((k0 >> 6) + h) * nrows + drow0 + c) * 64 + kc) = w; } }
    __syncthreads();
}

__device__ __forceinline__ void prep_transposes(const Params& p, LAS unsigned char* lds, bool late, int rank, int nrank) {
    unsigned char* ws = p.ws; LAS float* tl = (LAS float*)lds;
    constexpr int UPI = 88 * 4, DNI = 16 * 11;
    const int nup = late ? 3 * UPI : UPI, ndn = late ? 3 * DNI : DNI, nin = late ? 24 * 4 : 28 * 4, nsq = 16 * 4;
    const int T0 = nup, T1 = T0 + ndn, T2 = T1 + nin, T3 = T2 + nsq;
    for (int it = rank; it < T3; it += nrank) {
        if (it < T0) { const int li = (late ? 1 : 0) + it / UPI, r = it % UPI, jt = r / 4, kt = r % 4;
            const int pn = jt >> 2, bj = (jt >> 1) & 1, hh = jt & 1;
            const float* src = (bj ? p.ffn_w3 : p.ffn_w1) + (size_t)li * DM * FF;
            transpose_tile(tl, src, FF, pn * 128 + hh * 64, kt * 256, (bf16_t*)(ws + WS_WUP) + (size_t)li * 5632 * 1024, 5632, jt * 64, 64);
        } else if (it < T1) { const int q = it - T0, li = (late ? 1 : 0) + q / DNI, r = q % DNI, jt = r / 11, kt = r % 11;
            transpose_tile(tl, p.ffn_w2 + (size_t)li * FF * DM, DM, jt * 64, kt * 256, (bf16_t*)(ws + WS_WDN) + (size_t)li * 1024 * 2816, 1024, jt * 64, 64);
        } else if (it < T2) { const int q = it - T1, jt = q / 4, kt = q % 4;
            if (late) transpose_tile(tl, p.l1_w_in, 1536, jt * 64, kt * 256, (bf16_t*)(ws + WS_WL1IN), 1536, jt * 64, 64);
            else { const int nv = 1568 - jt * 64; transpose_tile(tl, p.l0_w_in, 2080, jt * 64, kt * 256, (bf16_t*)(ws + WS_WL0IN), 1792, jt * 64, nv < 0 ? 0 : (nv > 64 ? 64 : nv)); }
        } else { const int q = it - T2, jt = q / 4, kt = q % 4;
            if (late) transpose_tile(tl, p.l1_w_out, 1024, jt * 64, kt * 256, (bf16_t*)(ws + WS_WL1O), 1024, jt * 64, 64);
            else transpose_tile(tl, p.l0_w_out, 1024, jt * 64, kt * 256, (bf16_t*)(ws + WS_WL0O), 1024, jt * 64, 64);
        }
    }
}

__device__ __forceinline__ void prep_modgemv(const Params& p, LAS unsigned char* lds, int it_lo, int it_hi, int rank, int nrank) {
    const int tid = threadIdx.x; unsigned char* ws = p.ws;
    {
        LAS float* sc = (LAS float*)lds;
        LAS float* red = sc + 9 * 1024;
        bool loaded = false;
        for (int it = it_lo + rank; it < it_hi; it += nrank) {
            if (!loaded) { for (int i = tid; i < 9 * 1024; i += NTHR) { const float v = i < 1024 ? p.c_ctx[i] : p.c[i - 1024]; sc[i] = siluf(v); } loaded = true; __syncthreads(); }
            const int l = it / 144, r = it % 144, cg = r >> 2, ks = r & 3, w = tid >> 6, lane = tid & 63;
            const int k0 = ks * 256 + w * 32;
            const float* wp = p.mod_w + (size_t)l * DM * 9216 + (size_t)k0 * 9216 + cg * 256 + lane * 4;
            f32x4 a[9];
#pragma unroll
            for (int m = 0; m < 9; ++m) a[m] = (f32x4){0.f, 0.f, 0.f, 0.f};
            f32x4 wv[32];
#pragma unroll
            for (int k = 0; k < 32; ++k) wv[k] = __builtin_nontemporal_load((const f32x4*)(wp + (size_t)k * 9216));
#pragma unroll
            for (int k = 0; k < 32; ++k) {
#pragma unroll
                for (int m = 0; m < 9; ++m) a[m] += wv[k] * sc[m * 1024 + k0 + k]; }
#pragma unroll
            for (int m = 0; m < 9; ++m) *(LAS f32x4*)(red + (w * 9 + m) * 256 + lane * 4) = a[m];
            __syncthreads();
            for (int o = tid; o < 9 * 256; o += NTHR) { const int m = o >> 8, c = o & 255; float s = ks == 0 ? p.mod_b[l * 9216 + cg * 256 + c] : 0.f;
#pragma unroll
                for (int w2 = 0; w2 < 8; ++w2) s += red[(w2 * 9 + m) * 256 + c];
                unsafeAtomicAdd((float*)(ws + WS_MOD) + ((size_t)l * 9 + m) * 9216 + cg * 256 + c, s); }
            __syncthreads();
        }
        __syncthreads();
    }
}

__device__ __forceinline__ void phase_prep(const Params& p, LAS unsigned char* lds) {
    const int tid = threadIdx.x, G = gridDim.x, bid = blockIdx.x;
    unsigned char* ws = p.ws;
    prep_transposes(p, lds, false, bid, G);
    prep_modgemv(p, lds, 0, 144, bid, G);
    {
        const size_t gt = (size_t)bid * NTHR + tid, gn = (size_t)G * NTHR;
        bf16_t* dms = (bf16_t*)(ws + WS_DMS); bf16_t* dmp = (bf16_t*)(ws + WS_DMP);
        LAS f32x2* tw = (LAS f32x2*)lds;
        __syncthreads();
        for (int j = tid; j < 2048; j += NTHR) { float sn, cs; sincospif((float)j * (1.0f / 1024.0f), &sn, &cs); tw[j] = (f32x2){cs, -sn}; }
        __syncthreads();
        for (size_t i = gt; i < (size_t)2048 * 2048 / 2; i += gn) { const int t = (int)(i / 1024), k = (int)(i % 1024) * 2;
            const f32x2 w0 = tw[(t * k) & 2047], w1 = tw[(t * (k + 1)) & 2047];
            *(unsigned*)(dms + (size_t)t * 4096 + k) = cvt_pk_bf16(w0.x * 0.02209708691f, w1.x * 0.02209708691f);
            *(unsigned*)(dms + (size_t)t * 4096 + 2048 + k) = cvt_pk_bf16(w0.y * 0.02209708691f, w1.y * 0.02209708691f); }
        for (size_t i = gt; i < (size_t)256 * 256 / 2; i += gn) { const int t = (int)(i / 128), k = (int)(i % 128) * 2;
            const f32x2 w0 = tw[((t * k) & 255) * 8], w1 = tw[((t * (k + 1)) & 255) * 8];
            *(unsigned*)(dmp + (size_t)t * 512 + k) = cvt_pk_bf16(w0.x * 0.0625f, w1.x * 0.0625f);
            *(unsigned*)(dmp + (size_t)t * 512 + 256 + k) = cvt_pk_bf16(w0.y * 0.0625f, w1.y * 0.0625f); }
        __syncthreads();
        for (size_t i = gt; i < (size_t)2048 * 32; i += gn) { const int t = (int)(i >> 5), e = (int)(i & 31), fi = e & 15;
            const float inv = powf(10000.0f, -(float)fi / 16.0f); const float pos = (float)((e < 16) ? (t >> 6) : (t & 63)); const float ang = pos * inv;
            float sn, cs; sincosf(ang, &sn, &cs); ((f32x2*)(ws + WS_ROPE))[i] = (f32x2){cs, sn}; }
        for (size_t i = gt; i < (size_t)2048 * 256 / 4; i += gn) {
            const f32x4 kv = ((const f32x4*)p.cache_k)[i], vv = ((const f32x4*)p.cache_v)[i]; u32x2 a, b;
            a.x = cvt_pk_bf16(kv[0], kv[1]); a.y = cvt_pk_bf16(kv[2], kv[3]); b.x = cvt_pk_bf16(vv[0], vv[1]); b.y = cvt_pk_bf16(vv[2], vv[3]);
            ((u32x2*)(ws + WS_CTXK))[i] = a; ((u32x2*)(ws + WS_CTXV))[i] = b; }
    }
    {
        LAS float* wu = (LAS float*)lds;
        LAS float* ct = wu + 64 * 129;
        LAS float* st = ct + 128;
        for (int it = bid; it < 256; it += G) {
            const int g = it >> 6, kb = ((it >> 2) & 15) * 64, cq = it & 3;
            __syncthreads();
            if (tid < 128) { const float a = (float)tid * (1.0f / 64.0f); ct[tid] = cospif(a) * 0.08838834765f; st[tid] = sinpif(a) * 0.08838834765f; }
            for (int i = tid; i < 64 * 32; i += NTHR) { const int k = i >> 5, c4 = (i & 31) * 4; const f32x4 v = *(const f32x4*)(p.l0_w_in + (size_t)(kb + k) * 2080 + 1568 + g * 128 + c4);
                wu[k * 129 + c4] = v[0]; wu[k * 129 + c4 + 1] = v[1]; wu[k * 129 + c4 + 2] = v[2]; wu[k * 129 + c4 + 3] = v[3]; }
            __syncthreads();
            const int k = tid & 63, w = tid >> 6;
            bf16_t* wz = (bf16_t*)(ws + WS_WL0Z);
            for (int cc = 0; cc < 4; ++cc) { const int c = cq * 32 + w * 4 + cc; float ac = 0.f, as = 0.f;
                for (int c2 = 0; c2 < 128; ++c2) { const float wv = wu[k * 129 + c2]; const int j = (c * c2) & 127; ac += wv * ct[j]; as += wv * st[j]; }
                const size_t kb_ = (size_t)((kb + k) >> 6) * 1024, ko = (size_t)((kb + k) & 63);
                wz[(kb_ + g * 128 + c) * 64 + ko] = f2bf(ac); wz[(kb_ + 512 + g * 128 + c) * 64 + ko] = f2bf(as); }
        }
        __syncthreads();
    }
}

__device__ __forceinline__ void phase_norm(const Params& p, const float* xsrc_p, const float* xsrc_s, const float* g, const float* modl, int shift_chunk) {
    bf16_t* H = (bf16_t*)(p.ws + WS_H);
    const int lane = threadIdx.x & 63, gw = blockIdx.x * 8 + (threadIdx.x >> 6), nw = gridDim.x * 8;
    f32x4 gg[4];
#pragma unroll
    for (int i = 0; i < 4; ++i) gg[i] = *(const f32x4*)(g + i * 256 + lane * 4);
    for (int row = gw; row < R_ALL; row += 2 * nw) {
        int rj[2]; f32x4 v[2][4], sh[2][4], sc[2][4];
#pragma unroll
        for (int j = 0; j < 2; ++j) { rj[j] = row + j * nw < R_ALL ? row + j * nw : row;
            const float* xr = rj[j] < R_P ? xsrc_p + (size_t)rj[j] * DM : xsrc_s + (size_t)(rj[j] - R_P) * DM;
#pragma unroll
            for (int i = 0; i < 4; ++i) v[j][i] = *(const f32x4*)(xr + i * 256 + lane * 4); }
#pragma unroll
        for (int j = 0; j < 2; ++j) { const float* md = modl + (size_t)mod_index(rj[j]) * 9216 + shift_chunk * 1024;
#pragma unroll
            for (int i = 0; i < 4; ++i) { sh[j][i] = *(const f32x4*)(md + i * 256 + lane * 4); sc[j][i] = *(const f32x4*)(md + 1024 + i * 256 + lane * 4); } }
#pragma unroll
        for (int j = 0; j < 2; ++j) { float ss = 0.f;
#pragma unroll
            for (int i = 0; i < 4; ++i) ss += v[j][i][0] * v[j][i][0] + v[j][i][1] * v[j][i][1] + v[j][i][2] * v[j][i][2] + v[j][i][3] * v[j][i][3];
#pragma unroll
            for (int o = 32; o >= 1; o >>= 1) ss += __shfl_xor(ss, o);
            const float rinv = rsqrtf(ss * (1.0f / 1024.0f) + EPS);
            if (j == 0 || row + j * nw < R_ALL) {
#pragma unroll
                for (int i = 0; i < 4; ++i) { const int c = i * 256 + lane * 4;
                    const f32x4 y = (v[j][i] * rinv) * gg[i] * (sc[j][i] + 1.0f) + sh[j][i]; u32x2 w; w.x = cvt_pk_bf16(y[0], y[1]); w.y = cvt_pk_bf16(y[2], y[3]);
                    *(u32x2*)(H + ((size_t)(c >> 6) * R_ALL + rj[j]) * 64 + (c & 63)) = w; } } }
    }
}
__device__ __forceinline__ void phase_final_norm(const Params& p) {
    const int lane = threadIdx.x & 63, gw = blockIdx.x * 8 + (threadIdx.x >> 6), nw = gridDim.x * 8;
    f32x4 gg[4];
#pragma unroll
    for (int i = 0; i < 4; ++i) gg[i] = *(const f32x4*)(p.final_g + i * 256 + lane * 4);
    for (int row = gw; row < R_ALL; row += 4 * nw) {
        f32x4 v[4][4];
#pragma unroll
        for (int j = 0; j < 4; ++j) { const int r = row + j * nw < R_ALL ? row + j * nw : row; const float* xr = p.out + (size_t)r * DM;
#pragma unroll
            for (int i = 0; i < 4; ++i) v[j][i] = *(const f32x4*)(xr + i * 256 + lane * 4); }
#pragma unroll
        for (int j = 0; j < 4; ++j) { float ss = 0.f;
#pragma unroll
            for (int i = 0; i < 4; ++i) ss += v[j][i][0] * v[j][i][0] + v[j][i][1] * v[j][i][1] + v[j][i][2] * v[j][i][2] + v[j][i][3] * v[j][i][3];
#pragma unroll
            for (int o = 32; o >= 1; o >>= 1) ss += __shfl_xor(ss, o);
            const float rinv = rsqrtf(ss * (1.0f / 1024.0f) + EPS);
            if (row + j * nw < R_ALL) { float* xr = p.out + (size_t)(row + j * nw) * DM;
#pragma unroll
                for (int i = 0; i < 4; ++i) *(f32x4*)(xr + i * 256 + lane * 4) = (v[j][i] * rinv) * gg[i]; } }
    }
}

__device__ __forceinline__ bf16x8 lds_b8(const LAS bf16_t* p) { return *(const LAS bf16x8*)p; }
__device__ __forceinline__ void gla_unit(const Params& p, LAS unsigned char* lds, bool samp, int uidx) {
    constexpr int PT = 72;
    LAS bf16_t* Qd = (LAS bf16_t*)lds;
    LAS bf16_t* Ki = Qd + 64 * PT;
    LAS bf16_t* KeT = Ki + 64 * PT;
    LAS bf16_t* AT = KeT + 64 * PT;
    LAS bf16_t* VT = AT + 64 * PT;
    LAS bf16_t* ST = VT + 128 * PT;
    LAS float* LGs = (LAS float*)(ST + 128 * PT);
    LAS float* wg = LGs + 64 * 16;
    LAS float* bg = wg + 16 * 64;
    LAS float* tot = bg + 64;
    LAS float* dec = tot + 8 * 64;
    LAS float* Zs = dec + 64;
    const int tid = threadIdx.x, wv = tid >> 6, lane = tid & 63, l15 = lane & 15, quad = lane >> 4;
    const int b = uidx >> 3, h = (uidx >> 1) & 3, dir = uidx & 1;
    const int T = samp ? 2048 : 256, row0 = samp ? R_P + b * 2048 : b * 256, NC = T / 64;
    const bf16_t* P = (const bf16_t*)(p.ws + WS_P); const float* LG = (const float*)(p.ws + WS_LG);
    bf16_t* Od = dir ? (bf16_t*)(p.ws + WS_OB) : (bf16_t*)(p.ws + WS_H); const int old = dir ? 512 : 1024;
    __syncthreads();
    float bgr;
    { const float* wsrc = dir ? p.l0_w_gb : p.l0_w_gf; const float* bsrc = dir ? p.l0_b_gb : p.l0_b_gf;
      for (int i = tid; i < 1024; i += NTHR) wg[i] = wsrc[(i >> 6) * 256 + h * 64 + (i & 63)];
      bgr = bsrc[h * 64 + (tid & 63)]; }
    f32x4 S[4];
    { const float* s0 = samp ? (dir ? p.st_b : p.st_f) + (size_t)(b * 4 + h) * 64 * 128 : nullptr;
#pragma unroll
      for (int kt = 0; kt < 4; ++kt) {
#pragma unroll
          for (int r = 0; r < 4; ++r) S[kt][r] = s0 ? s0[(size_t)(kt * 16 + quad * 4 + r) * 128 + wv * 16 + l15] : 0.f;
          u32x2 w; w.x = cvt_pk_bf16(S[kt][0], S[kt][1]); w.y = cvt_pk_bf16(S[kt][2], S[kt][3]);
          *(LAS u32x2*)(ST + (wv * 16 + l15) * PT + kt * 16 + quad * 4) = w; } }
    const int dk = tid & 63, tg = wv;
    unsigned short rq[8], rk[8]; unsigned rv[8]; f32x4 rlg = (f32x4){0.f, 0.f, 0.f, 0.f};
#define GLA_PREFETCH(c_) do { \
        _Pragma("unroll") for (int e = 0; e < 8; ++e) { const int pos = (c_) * 64 + tg * 8 + e; const size_t r = (size_t)(row0 + (dir ? T - 1 - pos : pos)); \
            rq[e] = P[r * 1536 + h * 64 + dk]; rk[e] = P[r * 1536 + 256 + h * 64 + dk]; } \
        if (tid < 256) { const int pos = (c_) * 64 + (tid >> 2); const size_t r = (size_t)(row0 + (dir ? T - 1 - pos : pos)); rlg = *(const f32x4*)(LG + r * 32 + dir * 16 + (tid & 3) * 4); } \
        { const int dv = tid & 127, sg = tid >> 7; \
          _Pragma("unroll") for (int e2 = 0; e2 < 8; ++e2) { const int pos0 = (c_) * 64 + sg * 16 + e2 * 2; const size_t r0 = (size_t)(row0 + (dir ? T - 1 - pos0 : pos0)), r1 = (size_t)(row0 + (dir ? T - 2 - pos0 : pos0 + 1)); \
              const unsigned a_ = P[r0 * 1536 + 512 + h * 128 + dv], b_ = P[r1 * 1536 + 512 + h * 128 + dv]; rv[e2] = a_ | (b_ << 16); } } } while (0)
    GLA_PREFETCH(0);
    for (int c = 0; c < NC; ++c) {
        float qv[8], kv[8];
#pragma unroll
        for (int e = 0; e < 8; ++e) { qv[e] = bf2f(rq[e]); kv[e] = bf2f(rk[e]); }
        if (tid < 256) *(LAS f32x4*)(LGs + (tid >> 2) * 16 + (tid & 3) * 4) = rlg;
        { const int dv = tid & 127, sg = tid >> 7;
          *(LAS u32x4*)(VT + dv * PT + sg * 16) = (u32x4){rv[0], rv[1], rv[2], rv[3]}; *(LAS u32x4*)(VT + dv * PT + sg * 16 + 8) = (u32x4){rv[4], rv[5], rv[6], rv[7]}; }
        __syncthreads();
        if (c + 1 < NC) GLA_PREFETCH(c + 1);
        { const int ti = wv >> 1;
#pragma unroll
          for (int d2 = 0; d2 < 2; ++d2) { const int di = (wv & 1) * 2 + d2; f32x4 a = (f32x4){0.f, 0.f, 0.f, 0.f};
#pragma unroll
              for (int kk = 0; kk < 4; ++kk) a = __builtin_amdgcn_mfma_f32_16x16x4f32(LGs[(ti * 16 + l15) * 16 + kk * 4 + quad], wg[(kk * 4 + quad) * 64 + di * 16 + l15], a, 0, 0, 0);
              *(LAS f32x4*)(Zs + (di * 16 + l15) * 68 + ti * 16 + quad * 4) = a; } }
        __syncthreads();
        float la[8], run = 0.f;
        const f32x4 z0 = *(const LAS f32x4*)(Zs + dk * 68 + tg * 8), z1 = *(const LAS f32x4*)(Zs + dk * 68 + tg * 8 + 4);
#pragma unroll
        for (int e = 0; e < 8; ++e) { const float z = (e < 4 ? z0[e] : z1[e - 4]) + bgr;
            const float ls = fminf(z, 0.f) - __logf(1.0f + __expf(-fabsf(z)));
            run += ls * (1.0f / 16.0f); la[e] = run; }
        tot[tg * 64 + dk] = run;
        __syncthreads();
        float off = 0.f, blast = 0.f;
#pragma unroll
        for (int g2 = 0; g2 < 8; ++g2) { const float tv = tot[g2 * 64 + dk]; blast += tv; off += (g2 < tg) ? tv : 0.f; }
        { unsigned kw[4];
          const float ebl = __expf(blast);
#pragma unroll
          for (int e = 0; e < 8; e += 2) { const float b0 = off + la[e], b1 = off + la[e + 1];
              const float e0 = __expf(b0), e1 = __expf(b1), i0 = __expf(-b0), i1 = __expf(-b1);
              Qd[(tg * 8 + e) * PT + dk] = f2bf(qv[e] * 0.125f * e0); Qd[(tg * 8 + e + 1) * PT + dk] = f2bf(qv[e + 1] * 0.125f * e1);
              const float k0 = kv[e] * i0, k1 = kv[e + 1] * i1;
              Ki[(tg * 8 + e) * PT + dk] = f2bf(k0); Ki[(tg * 8 + e + 1) * PT + dk] = f2bf(k1);
              kw[e >> 1] = cvt_pk_bf16(k0 * ebl, k1 * ebl); }
          *(LAS u32x4*)(KeT + dk * PT + tg * 8) = (u32x4){kw[0], kw[1], kw[2], kw[3]};
          if (tg == 0) dec[dk] = ebl; }
        __syncthreads();
        { const int ti = wv >> 1;
#pragma unroll
          for (int s2 = 0; s2 < 2; ++s2) { const int sj = (wv & 1) * 2 + s2; f32x4 a = (f32x4){0.f, 0.f, 0.f, 0.f};
#pragma unroll
              for (int kk = 0; kk < 2; ++kk) a = __builtin_amdgcn_mfma_f32_16x16x32_bf16(lds_b8(Qd + (ti * 16 + l15) * PT + kk * 32 + quad * 8), lds_b8(Ki + (sj * 16 + l15) * PT + kk * 32 + quad * 8), a, 0, 0, 0);
#pragma unroll
              for (int r = 0; r < 4; ++r) { const int t = ti * 16 + quad * 4 + r, s = sj * 16 + l15; AT[t * PT + s] = f2bf(s <= t ? a[r] : 0.f); } } }
        __syncthreads();
#pragma unroll
        for (int ti = 0; ti < 4; ++ti) { f32x4 a = (f32x4){0.f, 0.f, 0.f, 0.f};
#pragma unroll
            for (int kk = 0; kk < 2; ++kk) a = __builtin_amdgcn_mfma_f32_16x16x32_bf16(lds_b8(VT + (wv * 16 + l15) * PT + kk * 32 + quad * 8), lds_b8(AT + (ti * 16 + l15) * PT + kk * 32 + quad * 8), a, 0, 0, 0);
#pragma unroll
            for (int kk = 0; kk < 2; ++kk) a = __builtin_amdgcn_mfma_f32_16x16x32_bf16(lds_b8(ST + (wv * 16 + l15) * PT + kk * 32 + quad * 8), lds_b8(Qd + (ti * 16 + l15) * PT + kk * 32 + quad * 8), a, 0, 0, 0);
            const int pos = c * 64 + ti * 16 + l15; const size_t r = (size_t)(row0 + (dir ? T - 1 - pos : pos));
            u32x2 w; w.x = cvt_pk_bf16(a[0], a[1]); w.y = cvt_pk_bf16(a[2], a[3]);
            *(u32x2*)(Od + r * old + h * 128 + wv * 16 + quad * 4) = w; }
#pragma unroll
        for (int kt = 0; kt < 4; ++kt) {
#pragma unroll
            for (int r = 0; r < 4; ++r) S[kt][r] *= dec[kt * 16 + quad * 4 + r];
#pragma unroll
            for (int kk = 0; kk < 2; ++kk) S[kt] = __builtin_amdgcn_mfma_f32_16x16x32_bf16(lds_b8(KeT + (kt * 16 + l15) * PT + kk * 32 + quad * 8), lds_b8(VT + (wv * 16 + l15) * PT + kk * 32 + quad * 8), S[kt], 0, 0, 0);
            u32x2 w; w.x = cvt_pk_bf16(S[kt][0], S[kt][1]); w.y = cvt_pk_bf16(S[kt][2], S[kt][3]);
            *(LAS u32x2*)(ST + (wv * 16 + l15) * PT + kt * 16 + quad * 4) = w; }
        __syncthreads();
    }
    if (!samp) { float* so = p.out + (dir ? OUT_SB : OUT_SF) + (size_t)(b * 4 + h) * 64 * 128;
#pragma unroll
        for (int kt = 0; kt < 4; ++kt)
#pragma unroll
            for (int r = 0; r < 4; ++r) so[(size_t)(kt * 16 + quad * 4 + r) * 128 + wv * 16 + l15] = S[kt][r]; }
}

__device__ __forceinline__ void dft_unit(const Params& p, LAS unsigned char* lds, bool samp, int uidx) {
    pg8::OneSrc S; EpiBf E;
    if (samp) { const int b = uidx >> 4, pm = (uidx >> 1) & 7, pn = uidx & 1;
        S.u0.a = (const char*)(p.ws + WS_DMS) + (size_t)pm * 256 * 4096 * 2; S.u0.b = (const char*)(p.ws + WS_ZTS) + ((size_t)b * 512 + pn * 256) * 4096 * 2; S.u0.pm = pm; S.u0.pn = pn;
        E.O = (bf16_t*)(p.ws + WS_H) + (size_t)(R_P + b * 2048) * 1024 + 512; E.ldc = 1024;
        pg8::gemm_phase(lds, 4096, 4096, 4096, S, E);
    } else { const int b = uidx >> 1, pn = uidx & 1;
        S.u0.a = (const char*)(p.ws + WS_DMP); S.u0.b = (const char*)(p.ws + WS_ZTP) + ((size_t)b * 512 + pn * 256) * 512 * 2; S.u0.pm = 0; S.u0.pn = pn;
        E.O = (bf16_t*)(p.ws + WS_H) + (size_t)(b * 256) * 1024 + 512; E.ldc = 1024;
        pg8::gemm_phase(lds, 512, 512, 512, S, E);
    }
}

__device__ __forceinline__ void phase_combine(const Params& p) {
    const int lane = threadIdx.x & 63, gw = blockIdx.x * 8 + (threadIdx.x >> 6), nw = gridDim.x * 8;
    bf16_t* MIX = (bf16_t*)(p.ws + WS_H); const bf16_t* OB = (const bf16_t*)(p.ws + WS_OB); const bf16_t* P = (const bf16_t*)(p.ws + WS_P);
    const int c0 = lane * 8;
    f32x4 g0 = *(const f32x4*)(p.l0_g_head + (c0 & 127)), g1 = *(const f32x4*)(p.l0_g_head + (c0 & 127) + 4);
    for (int row0 = gw; row0 < R_ALL; row0 += 4 * nw) {
        u32x4 av[4], bv[4], ov[4];
#pragma unroll
        for (int j = 0; j < 4; ++j) { const int r = row0 + j * nw < R_ALL ? row0 + j * nw : row0;
            av[j] = *(const u32x4*)(MIX + (size_t)r * 1024 + c0); bv[j] = *(const u32x4*)(OB + (size_t)r * 512 + c0); ov[j] = *(const u32x4*)(P + (size_t)r * 1536 + 1024 + c0); }
#pragma unroll
        for (int j = 0; j < 4; ++j) { const int row = row0 + j * nw; const u32x4 a = av[j], bq = bv[j], og = ov[j];
        float o[8], gv[8];
        o[0] = bflo(a.x) + bflo(bq.x); o[1] = bfhi(a.x) + bfhi(bq.x); o[2] = bflo(a.y) + bflo(bq.y); o[3] = bfhi(a.y) + bfhi(bq.y);
        o[4] = bflo(a.z) + bflo(bq.z); o[5] = bfhi(a.z) + bfhi(bq.z); o[6] = bflo(a.w) + bflo(bq.w); o[7] = bfhi(a.w) + bfhi(bq.w);
        gv[0] = bflo(og.x); gv[1] = bfhi(og.x); gv[2] = bflo(og.y); gv[3] = bfhi(og.y); gv[4] = bflo(og.z); gv[5] = bfhi(og.z); gv[6] = bflo(og.w); gv[7] = bfhi(og.w);
        float ss = 0.f;
#pragma unroll
        for (int e = 0; e < 8; ++e) ss += o[e] * o[e];
#pragma unroll
        for (int s = 8; s >= 1; s >>= 1) ss += __shfl_xor(ss, s);
        const float rinv = rsqrtf(ss * (1.0f / 128.0f) + EPS);
        float y[8];
#pragma unroll
        for (int e = 0; e < 8; ++e) y[e] = o[e] * rinv * (e < 4 ? g0[e] : g1[e - 4]) * siluf(gv[e]);
        u32x4 w; w.x = cvt_pk_bf16(y[0], y[1]); w.y = cvt_pk_bf16(y[2], y[3]); w.z = cvt_pk_bf16(y[4], y[5]); w.w = cvt_pk_bf16(y[6], y[7]);
        if (row < R_ALL) *(u32x4*)(MIX + (size_t)row * 1024 + c0) = w; }
    }
}

__device__ __forceinline__ void attn_unit(const Params& p, LAS unsigned char* lds, int u) {
    constexpr int PT = 72;
    LAS bf16_t* Ks = (LAS bf16_t*)lds;
    LAS bf16_t* VTs = Ks + 64 * PT;
    const int tid = threadIdx.x, wv = tid >> 6, lane = tid & 63, l15 = lane & 15, quad = lane >> 4;
    const bf16_t* Qb = (const bf16_t*)(p.ws + WS_Q); const bf16_t* Kb = (const bf16_t*)(p.ws + WS_K); const bf16_t* Vb = (const bf16_t*)(p.ws + WS_V);
    const bf16_t* CK = (const bf16_t*)(p.ws + WS_CTXK); const bf16_t* CV = (const bf16_t*)(p.ws + WS_CTXV);
    bf16_t* Ob = (bf16_t*)(p.ws + WS_H);
    bool samp; int b, kvh, qb, row0, seq0;
    if (u < 512) { samp = true; b = u >> 6; kvh = (u >> 4) & 3; qb = u & 15; seq0 = R_P + b * 2048; row0 = seq0 + qb * 128; }
    else { const int v = u - 512; samp = false; b = v >> 3; kvh = (v >> 1) & 3; qb = v & 1; seq0 = b * 256; row0 = seq0 + qb * 128; }
    const int qrow = row0 + wv * 16 + l15, qpos = qb * 128 + wv * 16 + l15;
    bf16x8 Qr[4][2];
#pragma unroll
    for (int g = 0; g < 4; ++g)
#pragma unroll
        for (int kk = 0; kk < 2; ++kk) Qr[g][kk] = *(const bf16x8*)(Qb + (size_t)qrow * 1024 + (kvh * 4 + g) * 64 + kk * 32 + quad * 8);
    f32x4 O[4][4]; float mrun[4], lrun[4];
#pragma unroll
    for (int g = 0; g < 4; ++g) { mrun[g] = p.l1_sink[kvh * 4 + g] * 1.44269504089f; lrun[g] = quad == 0 ? 1.f : 0.f;
#pragma unroll
        for (int dt = 0; dt < 4; ++dt) O[g][dt] = (f32x4){0.f, 0.f, 0.f, 0.f}; }
    const int ntile = samp ? 10 : 4;
    const int skey = tid >> 3, shc = (tid & 7) * 8;
    const int skrow = ((skey >> 5) * 2 + ((skey >> 2) & 1)) * 16 + ((skey >> 3) & 3) * 4 + (skey & 3);
    const int vkey = tid & 63, vhc = (tid >> 6) * 8;
#define ATT_TILE_SRC(ti_, kp_, vp_) do { \
        if (samp) { if ((ti_) < 4) { const size_t r0 = (size_t)(b * 256 + (ti_) * 64); kp_ = CK + (r0 + skey) * 256 + kvh * 64 + shc; vp_ = CV + (r0 + vkey) * 256 + kvh * 64 + vhc; } \
                    else { int kp0 = qb * 128 - 128 + ((ti_) - 4) * 64; kp0 = kp0 < 0 ? 0 : (kp0 > 2048 - 64 ? 2048 - 64 : kp0); const size_t r0 = (size_t)(seq0 + kp0); kp_ = Kb + (r0 + skey) * 256 + kvh * 64 + shc; vp_ = Vb + (r0 + vkey) * 256 + kvh * 64 + vhc; } } \
        else { const size_t r0 = (size_t)(seq0 + (ti_) * 64); kp_ = Kb + (r0 + skey) * 256 + kvh * 64 + shc; vp_ = Vb + (r0 + vkey) * 256 + kvh * 64 + vhc; } } while (0)
    u32x4 kq, vq;
    { const bf16_t* kp; const bf16_t* vp; ATT_TILE_SRC(0, kp, vp); kq = *(const u32x4*)kp; vq = *(const u32x4*)vp; }
    for (int ti = 0; ti < ntile; ++ti) {
        const int kpos0 = qb * 128 - 128 + (ti - 4) * 64;
        bool skipw = false, masked = false;
        if (samp && ti >= 4) { const int i0 = qb * 128 + __builtin_amdgcn_readfirstlane(wv) * 16, i1 = i0 + 15;
            skipw = (kpos0 < 0) || (kpos0 >= 2048) || (kpos0 + 63 < i0 - 128) || (kpos0 > i1 + 128);
            masked = !((kpos0 >= i1 - 128) && (kpos0 + 63 <= i0 + 128)); }
        __syncthreads();
        { *(LAS u32x4*)(Ks + skrow * PT + shc) = kq;
          const int key = vkey, hc = vhc;
          VTs[(hc + 0) * PT + key] = (bf16_t)(vq.x & 0xffff); VTs[(hc + 1) * PT + key] = (bf16_t)(vq.x >> 16);
          VTs[(hc + 2) * PT + key] = (bf16_t)(vq.y & 0xffff); VTs[(hc + 3) * PT + key] = (bf16_t)(vq.y >> 16);
          VTs[(hc + 4) * PT + key] = (bf16_t)(vq.z & 0xffff); VTs[(hc + 5) * PT + key] = (bf16_t)(vq.z >> 16);
          VTs[(hc + 6) * PT + key] = (bf16_t)(vq.w & 0xffff); VTs[(hc + 7) * PT + key] = (bf16_t)(vq.w >> 16); }
        __syncthreads();
        if (ti + 1 < ntile) { const bf16_t* kp; const bf16_t* vp; ATT_TILE_SRC(ti + 1, kp, vp); kq = *(const u32x4*)kp; vq = *(const u32x4*)vp; }
        if (!skipw)
#pragma unroll
        for (int g = 0; g < 4; ++g) {
            f32x4 s[4];
#pragma unroll
            for (int kt = 0; kt < 4; ++kt) { s[kt] = (f32x4){0.f, 0.f, 0.f, 0.f};
#pragma unroll
                for (int kk = 0; kk < 2; ++kk) s[kt] = __builtin_amdgcn_mfma_f32_16x16x32_bf16(lds_b8(Ks + (kt * 16 + l15) * PT + kk * 32 + quad * 8), Qr[g][kk], s[kt], 0, 0, 0); }
            if (masked) {
#pragma unroll
                for (int kt = 0; kt < 4; ++kt)
#pragma unroll
                    for (int r = 0; r < 4; ++r) { const int d = qpos - (kpos0 + (kt >> 1) * 32 + quad * 8 + (kt & 1) * 4 + r); if (d > 128 || d < -128) s[kt][r] = -INFINITY; } }
            float mx = fmaxf(fmaxf(fmaxf(s[0][0], s[0][1]), fmaxf(s[0][2], s[0][3])), fmaxf(fmaxf(s[1][0], s[1][1]), fmaxf(s[1][2], s[1][3])));
            mx = fmaxf(mx, fmaxf(fmaxf(fmaxf(s[2][0], s[2][1]), fmaxf(s[2][2], s[2][3])), fmaxf(fmaxf(s[3][0], s[3][1]), fmaxf(s[3][2], s[3][3]))));
            mx = max_x16_x32(mx);
            if (__any(mx > mrun[g] + 4.0f)) {
                const float mn = fmaxf(mrun[g], mx), alpha = __builtin_amdgcn_exp2f(mrun[g] - mn); mrun[g] = mn;
                lrun[g] *= alpha;
#pragma unroll
                for (int dt = 0; dt < 4; ++dt) O[g][dt] *= alpha;
            }
            const float mn = mrun[g];
            float ls = 0.f;
#pragma unroll
            for (int kt = 0; kt < 4; ++kt)
#pragma unroll
                for (int r = 0; r < 4; ++r) { s[kt][r] = __builtin_amdgcn_exp2f(s[kt][r] - mn); ls += s[kt][r]; }
            lrun[g] += ls;
#pragma unroll
            for (int kk = 0; kk < 2; ++kk) {
                u32x4 pw; pw.x = cvt_pk_bf16(s[2 * kk][0], s[2 * kk][1]); pw.y = cvt_pk_bf16(s[2 * kk][2], s[2 * kk][3]); pw.z = cvt_pk_bf16(s[2 * kk + 1][0], s[2 * kk + 1][1]); pw.w = cvt_pk_bf16(s[2 * kk + 1][2], s[2 * kk + 1][3]);
                const bf16x8 pb = __builtin_bit_cast(bf16x8, pw);
#pragma unroll
                for (int dt = 0; dt < 4; ++dt) {
                    O[g][dt] = __builtin_amdgcn_mfma_f32_16x16x32_bf16(lds_b8(VTs + (dt * 16 + l15) * PT + kk * 32 + quad * 8), pb, O[g][dt], 0, 0, 0); } }
            asm volatile("" ::: "memory");
        }
    }
#pragma unroll
    for (int g = 0; g < 4; ++g) { const float l = sum_x16_x32(lrun[g]); const float inv = 1.0f / l;
#pragma unroll
        for (int dt = 0; dt < 4; ++dt) { const f32x4 o = O[g][dt] * inv; u32x2 w; w.x = cvt_pk_bf16(o[0], o[1]); w.y = cvt_pk_bf16(o[2], o[3]);
            *(u32x2*)(Ob + (size_t)qrow * 1024 + (kvh * 4 + g) * 64 + dt * 16 + quad * 4) = w; } }
}

__device__ __forceinline__ void run_up(const Params& p, LAS unsigned char* lds, int li) {
    pg8::GridSrc S; S.init(p.ws + WS_H, 64, p.ws + WS_WUP + (size_t)li * 5632 * 1024 * 2, 64, R_ALL, 5632, gridDim.x, blockIdx.x, 192);
    EpiUp E{(bf16_t*)(p.ws + WS_ACT)};
    pg8::gemm_phase(lds, 64, 64, 1024, S, E, (size_t)R_ALL * 128, (size_t)5632 * 128);
}
__device__ __forceinline__ void run_down(const Params& p, LAS unsigned char* lds, int li, int layer, int gchunk, bool first) {
    pg8::GridSrc S; S.init(p.ws + WS_ACT, 64, p.ws + WS_WDN + (size_t)li * 1024 * 2816 * 2, 64, R_ALL, 1024, gridDim.x, blockIdx.x, 192);
    EpiRes E{p.out, first ? p.x_prompt : nullptr, p.x_sample, (const float*)(p.ws + WS_MOD) + (size_t)layer * 9 * 9216, gchunk, 0.5f};
    pg8::gemm_phase(lds, 64, 64, FF, S, E, (size_t)R_ALL * 128, (size_t)1024 * 128);
}
__device__ __forceinline__ void run_wout(const Params& p, LAS unsigned char* lds, int layer) {
    pg8::GridSrc S; S.init(p.ws + WS_H, 1024, p.ws + (layer ? WS_WL1O : WS_WL0O), 64, R_ALL, 1024, gridDim.x, blockIdx.x, 192);
    EpiRes E{p.out, nullptr, nullptr, (const float*)(p.ws + WS_MOD) + (size_t)layer * 9 * 9216, 5, 1.0f};
    pg8::gemm_phase(lds, 1024, 64, 1024, S, E, 128, (size_t)1024 * 128);
}

__device__ __forceinline__ void run_l0in(const Params& p, LAS unsigned char* lds) {
    const int G = gridDim.x;
    { pg8::GridSrc S; S.init(p.ws + WS_H, 64, p.ws + WS_WL0IN, 64, R_ALL, 1792, G, blockIdx.x, 192);
      EpiL0In E{(bf16_t*)(p.ws + WS_P), (float*)(p.ws + WS_LG)}; pg8::gemm_phase(lds, 64, 64, 1024, S, E, (size_t)R_ALL * 128, (size_t)1792 * 128); }
    { const int c2 = (int)((blockIdx.x + G - (896 % G)) % G);
      pg8::GridSrc S; S.init(p.ws + WS_WL0Z, 64, p.ws + WS_H, 64, 1024, R_ALL, G, c2);
      EpiL0Z E{(bf16_t*)(p.ws + WS_ZTS), (bf16_t*)(p.ws + WS_ZTP)}; pg8::gemm_phase(lds, 64, 64, 1024, S, E, (size_t)1024 * 128, (size_t)R_ALL * 128); }
}
__device__ __forceinline__ void run_l0mix(const Params& p0, LAS unsigned char* lds) {
    const int G = gridDim.x;
    { Params p = p0; { size_t z_ = 0; asm volatile("" : "+s"(z_)); p.ws = p0.ws + z_; p.out = p0.out + z_; }
      for (int w = blockIdx.x; w < 128; w += G) { if (DBG_DFT) dft_unit(p, lds, true, w); } }
    { Params p = p0; { size_t z_ = 0; asm volatile("" : "+s"(z_)); p.ws = p0.ws + z_; p.out = p0.out + z_; }
      for (int w = blockIdx.x; w < 192; w += G) { if (w < 128) continue; gla_unit(p, lds, true, w - 128); } }
    { Params p = p0; { size_t z_ = 0; asm volatile("" : "+s"(z_)); p.ws = p0.ws + z_; p.out = p0.out + z_; }
      for (int w = blockIdx.x; w < 256; w += G) { if (w < 192) continue; if (DBG_DFT) dft_unit(p, lds, false, w - 192); } }
    { Params p = p0; { size_t z_ = 0; asm volatile("" : "+s"(z_)); p.ws = p0.ws + z_; p.out = p0.out + z_; }
      for (int w = blockIdx.x; w < 256; w += G) { if (w < 192) continue; for (int j = 0; j < 4; ++j) gla_unit(p, lds, false, (w - 192) * 4 + j); } }
    { Params p = p0; { size_t z_ = 0; asm volatile("" : "+s"(z_)); p.ws = p0.ws + z_; p.out = p0.out + z_; }
      if (G == 256) { const int b = blockIdx.x; if (b < 128 || b >= 192) { const int rk = b < 128 ? b : b - 64; __syncthreads(); prep_modgemv(p, lds, 144, 288, rk, 192); prep_transposes(p, lds, true, rk, 192); } }
      else { __syncthreads(); prep_modgemv(p, lds, 144, 288, blockIdx.x, G); prep_transposes(p, lds, true, blockIdx.x, G); } }
}
__device__ __forceinline__ void run_qkv(const Params& p, LAS unsigned char* lds) {
    pg8::GridSrc S; S.init(p.ws + WS_H, 64, p.ws + WS_WL1IN, 64, R_ALL, 1536, gridDim.x, blockIdx.x, 192);
    EpiQKV E{(bf16_t*)(p.ws + WS_Q), (bf16_t*)(p.ws + WS_K), (bf16_t*)(p.ws + WS_V), p.out + OUT_KC, p.out + OUT_VC, (const float*)(p.ws + WS_ROPE)};
    pg8::gemm_phase(lds, 64, 64, 1024, S, E, (size_t)R_ALL * 128, (size_t)1536 * 128);
}
__device__ __forceinline__ void run_attn(const Params& p, LAS unsigned char* lds) {
    for (int u = blockIdx.x; u < 768; u += gridDim.x) attn_unit(p, lds, u);
}

__device__ __forceinline__ void phase_dump(const Params& p) {
    const bf16_t* MIX = (const bf16_t*)(p.ws + WS_H); const bf16_t* OB = (const bf16_t*)(p.ws + WS_OB);
    for (size_t i = (size_t)blockIdx.x * NTHR + threadIdx.x; i < (size_t)R_ALL * 1024; i += (size_t)gridDim.x * NTHR) {
        const size_t row = i >> 10; const int c = (int)(i & 1023);
        p.out[i] = c < 512 ? bf2f(MIX[row * 1024 + c]) : bf2f(OB[row * 512 + c - 512]); }
}
#ifndef PH_MASK
#define PH_MASK 0xFFFFFFFFull
#endif
__global__ void __launch_bounds__(NTHR, 2) mega(Params p) {
    extern __shared__ __attribute__((aligned(16))) unsigned char lds_raw[];
    LAS unsigned char* lds = (LAS unsigned char*)lds_raw;
    XcdBarrier xbar; xbar.bar = nullptr; xbar.x = 0; xbar.st = nullptr;
    if (p.coop) {
        volatile LAS unsigned* st = (volatile LAS unsigned*)(lds + LDS_BYTES - 16);
        if (threadIdx.x < 4) st[threadIdx.x] = 0u;
        __syncthreads();
        xbar = xcd_barrier_post((unsigned*)(p.ws + WS_BAR), st);
        if (p.coop == 2) cg::this_grid().sync();
    }
#define SEAM(k) do { if (p.coop && (k) + 1 < p.ph_hi) { xcd_barrier(xbar); } } while (0)
#ifndef DUP_MASK
#define DUP_MASK 0ull
#endif
#ifndef EXTRA_SYNCS
#define EXTRA_SYNCS 0
#endif
#define PHASE(k, body) if (((PH_MASK >> (k)) & 1ull) && p.ph_lo <= (k) && (k) < p.ph_hi) { \
    if ((DUP_MASK >> (k)) & 1ull) { Params q = p; { size_t z_ = 0; asm volatile("" : "+s"(z_)); q.ws = p.ws + z_; q.out = p.out + z_; } body; if (p.coop) xcd_barrier(xbar); } \
    { Params q = p; { size_t z_ = 0; asm volatile("" : "+s"(z_)); q.ws = p.ws + z_; q.out = p.out + z_; } body; } SEAM(k); }
    for (int es = 0; es < EXTRA_SYNCS; ++es) if (p.coop) xcd_barrier(xbar);
    PHASE(0, phase_prep(q, lds))
    PHASE(1, phase_norm(q, q.x_prompt, q.x_sample, q.norm_g + 0, (const float*)(q.ws + WS_MOD), 0))
    PHASE(2, run_up(q, lds, 0))
    PHASE(3, run_down(q, lds, 0, 0, 2, true))
    PHASE(4, phase_norm(q, q.out, q.out + (size_t)R_P * DM, q.norm_g + 1024, (const float*)(q.ws + WS_MOD), 3))
    PHASE(5, run_l0in(q, lds))
    PHASE(6, run_l0mix(q, lds))
    PHASE(7, phase_combine(q))
    PHASE(8, run_wout(q, lds, 0))
    PHASE(9, phase_norm(q, q.out, q.out + (size_t)R_P * DM, q.norm_g + 2048, (const float*)(q.ws + WS_MOD), 6))
    PHASE(10, run_up(q, lds, 1))
    PHASE(11, run_down(q, lds, 1, 0, 8, false))
    PHASE(12, phase_norm(q, q.out, q.out + (size_t)R_P * DM, q.norm_g + 3072, (const float*)(q.ws + WS_MOD) + 9 * 9216, 0))
    PHASE(13, run_up(q, lds, 2))
    PHASE(14, run_down(q, lds, 2, 1, 2, false))
    PHASE(15, phase_norm(q, q.out, q.out + (size_t)R_P * DM, q.norm_g + 3072 + 1024, (const float*)(q.ws + WS_MOD) + 9 * 9216, 3))
    PHASE(16, run_qkv(q, lds))
    PHASE(17, run_attn(q, lds))
    PHASE(18, run_wout(q, lds, 1))
    PHASE(19, phase_norm(q, q.out, q.out + (size_t)R_P * DM, q.norm_g + 3072 + 2048, (const float*)(q.ws + WS_MOD) + 9 * 9216, 6))
    PHASE(20, run_up(q, lds, 3))
    PHASE(21, run_down(q, lds, 3, 1, 8, false))
    PHASE(22, phase_final_norm(q))
    PHASE(23, phase_dump(q))
#undef PHASE
#undef SEAM
}

constexpr int N_PHASES = 23;
constexpr int RUN_PHASES = N_PHASES;
#ifndef ONE_LAUNCH
#define ONE_LAUNCH 1
#endif

extern "C" void kernel_launch(void* const* d_in, const int* in_sizes, int n_in, void* d_out, int out_size, void* d_ws, size_t ws_size, hipStream_t stream) {
    static int grid = 0;
    if (grid == 0) {
        if (n_in != 25 || ws_size < WS_END) { fprintf(stderr, "kernel_launch: unexpected n_in %d or ws_size %zu (need %zu)\n", n_in, ws_size, (size_t)WS_END); grid = -1; return; }
        int dev = 0, cus = 0, per_cu = 0;
        hipGetDevice(&dev); hipDeviceGetAttribute(&cus, hipDeviceAttributeMultiprocessorCount, dev);
        if (hipFuncSetAttribute((const void*)mega, hipFuncAttributeMaxDynamicSharedMemorySize, LDS_BYTES) != hipSuccess) { fprintf(stderr, "kernel_launch: hipFuncSetAttribute failed\n"); grid = -1; return; }
        hipOccupancyMaxActiveBlocksPerMultiprocessor(&per_cu, (const void*)mega, NTHR, LDS_BYTES);
        (void)hipGetLastError();
        if (per_cu < 1) per_cu = 1;
        if (per_cu > 1) per_cu = 1;
        grid = cus * per_cu;
    }
    if (grid < 0) return;
    Params p{};
    p.x_prompt = (const float*)d_in[0]; p.x_sample = (const float*)d_in[1]; p.st_f = (const float*)d_in[2]; p.st_b = (const float*)d_in[3];
    p.cache_k = (const float*)d_in[4]; p.cache_v = (const float*)d_in[5]; p.c = (const float*)d_in[6]; p.c_ctx = (const float*)d_in[7];
    p.mod_w = (const float*)d_in[8]; p.mod_b = (const float*)d_in[9]; p.norm_g = (const float*)d_in[10];
    p.ffn_w1 = (const float*)d_in[11]; p.ffn_w3 = (const float*)d_in[12]; p.ffn_w2 = (const float*)d_in[13];
    p.l0_w_in = (const float*)d_in[14]; p.l0_w_gf = (const float*)d_in[15]; p.l0_b_gf = (const float*)d_in[16]; p.l0_w_gb = (const float*)d_in[17]; p.l0_b_gb = (const float*)d_in[18];
    p.l0_g_head = (const float*)d_in[19]; p.l0_w_out = (const float*)d_in[20]; p.l1_w_in = (const float*)d_in[21]; p.l1_sink = (const float*)d_in[22]; p.l1_w_out = (const float*)d_in[23];
    p.final_g = (const float*)d_in[24];
    p.out = (float*)d_out; p.ws = (unsigned char*)d_ws;
#if ONE_LAUNCH
    if (hipMemsetAsync((char*)d_ws + WS_MOD, 0, WS_BAR + 16384 - WS_MOD, stream) != hipSuccess) { fprintf(stderr, "kernel_launch: memset failed\n"); return; }
    p.ph_lo = 0; p.ph_hi = N_PHASES; p.coop = 1; p.pad = 0;
    void* args[] = {&p};
    hipError_t e = hipLaunchCooperativeKernel((const void*)mega, dim3(grid), dim3(NTHR), args, LDS_BYTES, stream);
    if (e != hipSuccess) fprintf(stderr, "cooperative launch failed: %s (grid %d)\n", hipGetErrorString(e), grid);
#else
    for (int ph = 0; ph < RUN_PHASES; ++ph) {
        p.ph_lo = ph; p.ph_hi = ph + 1; p.coop = 0; p.pad = 0;
        hipLaunchKernelGGL(mega, dim3(grid), dim3(NTHR), LDS_BYTES, stream, p);
    }
#endif
}
```

```cpp
#include <hip/hip_runtime.h>
#include <hip/hip_cooperative_groups.h>
#include <cstdio>
namespace cg = cooperative_groups;

#define LAS __attribute__((address_space(3)))
typedef unsigned short bf16_t;
typedef short bf16x8 __attribute__((ext_vector_type(8)));
typedef float f32x4 __attribute__((ext_vector_type(4)));
typedef float f32x2 __attribute__((ext_vector_type(2)));
typedef unsigned u32x4 __attribute__((ext_vector_type(4)));
typedef unsigned u32x2 __attribute__((ext_vector_type(2)));

constexpr int R_ALL = 24576, R_P = 8192, DM = 1024, FF = 2816;
constexpr int NTHR = 512;
#define DBG_DFT 1
constexpr int LDS_BYTES = 147456;
constexpr float EPS = 1e-6f;

constexpr size_t AL(size_t x) { return (x + 255) & ~(size_t)255; }
constexpr size_t WS_MOD   = 0;
constexpr size_t WS_BAR   = AL(WS_MOD + (size_t)2 * 9 * 9216 * 4);
constexpr size_t WS_ROPE  = AL(WS_BAR + (size_t)16384);
constexpr size_t WS_WUP   = AL(WS_ROPE + (size_t)2048 * 32 * 2 * 4);
constexpr size_t WS_WDN   = AL(WS_WUP + (size_t)4 * 5632 * 1024 * 2);
constexpr size_t WS_WL0IN = AL(WS_WDN + (size_t)4 * 1024 * 2816 * 2);
constexpr size_t WS_WL0Z  = AL(WS_WL0IN + (size_t)1792 * 1024 * 2);
constexpr size_t WS_WL0O  = AL(WS_WL0Z + (size_t)1024 * 1024 * 2);
constexpr size_t WS_WL1IN = AL(WS_WL0O + (size_t)1024 * 1024 * 2);
constexpr size_t WS_WL1O  = AL(WS_WL1IN + (size_t)1536 * 1024 * 2);
constexpr size_t WS_DMS   = AL(WS_WL1O + (size_t)1024 * 1024 * 2);
constexpr size_t WS_DMP   = AL(WS_DMS + (size_t)2048 * 4096 * 2);
constexpr size_t WS_CTXK  = AL(WS_DMP + (size_t)256 * 512 * 2);
constexpr size_t WS_CTXV  = AL(WS_CTXK + (size_t)2048 * 256 * 2);
constexpr size_t WS_H     = AL(WS_CTXV + (size_t)2048 * 256 * 2);
constexpr size_t WS_OB    = AL(WS_H + (size_t)R_ALL * 1024 * 2);
constexpr size_t WS_ACT   = AL(WS_OB + (size_t)R_ALL * 512 * 2);
constexpr size_t WS_END   = AL(WS_ACT + (size_t)R_ALL * 2816 * 2 + (size_t)262144);
constexpr size_t WS_P     = WS_ACT;
constexpr size_t WS_LG    = AL(WS_P + (size_t)R_ALL * 1536 * 2);
constexpr size_t WS_ZTS   = AL(WS_LG + (size_t)R_ALL * 32 * 4);
constexpr size_t WS_ZTP   = AL(WS_ZTS + (size_t)8 * 512 * 4096 * 2);
static_assert(WS_ZTP + (size_t)32 * 512 * 512 * 2 <= WS_END, "overlay");
constexpr size_t WS_Q     = WS_ACT;
constexpr size_t WS_K     = AL(WS_Q + (size_t)R_ALL * 1024 * 2);
constexpr size_t WS_V     = AL(WS_K + (size_t)R_ALL * 256 * 2);

constexpr size_t OUT_SF = (size_t)R_ALL * 1024, OUT_SB = OUT_SF + 1048576, OUT_KC = OUT_SB + 1048576, OUT_VC = OUT_KC + 2097152;

struct Params {
    const float* x_prompt; const float* x_sample; const float* st_f; const float* st_b; const float* cache_k; const float* cache_v;
    const float* c; const float* c_ctx; const float* mod_w; const float* mod_b; const float* norm_g;
    const float* ffn_w1; const float* ffn_w3; const float* ffn_w2;
    const float* l0_w_in; const float* l0_w_gf; const float* l0_b_gf; const float* l0_w_gb; const float* l0_b_gb; const float* l0_g_head; const float* l0_w_out;
    const float* l1_w_in; const float* l1_sink; const float* l1_w_out; const float* final_g;
    float* out; unsigned char* ws;
    int ph_lo, ph_hi, coop, pad;
};

typedef __bf16 bf16x2_t __attribute__((ext_vector_type(2)));
__device__ __forceinline__ unsigned cvt_pk_bf16(float lo, float hi) { const f32x2 v = (f32x2){lo, hi}; return __builtin_bit_cast(unsigned, __builtin_convertvector(v, bf16x2_t)); }
__device__ __forceinline__ bf16_t f2bf(float f) { return (bf16_t)(cvt_pk_bf16(f, 0.f) & 0xffffu); }
__device__ __forceinline__ float bf2f(bf16_t b) { return __uint_as_float(((unsigned)b) << 16); }
__device__ __forceinline__ float bflo(unsigned w) { return __uint_as_float(w << 16); }
__device__ __forceinline__ float bfhi(unsigned w) { return __uint_as_float(w & 0xffff0000u); }
__device__ __forceinline__ float siluf(float a) { return a * __builtin_amdgcn_rcpf(1.0f + __expf(-a)); }
__device__ __forceinline__ float max_x16_x32(float v) {
    u32x2 a = __builtin_amdgcn_permlane16_swap(__float_as_uint(v), __float_as_uint(v), false, false); v = fmaxf(__uint_as_float(a.x), __uint_as_float(a.y));
    u32x2 b = __builtin_amdgcn_permlane32_swap(__float_as_uint(v), __float_as_uint(v), false, false); return fmaxf(__uint_as_float(b.x), __uint_as_float(b.y));
}
__device__ __forceinline__ float sum_x16_x32(float v) {
    u32x2 a = __builtin_amdgcn_permlane16_swap(__float_as_uint(v), __float_as_uint(v), false, false); v = __uint_as_float(a.x) + __uint_as_float(a.y);
    u32x2 b = __builtin_amdgcn_permlane32_swap(__float_as_uint(v), __float_as_uint(v), false, false); return __uint_as_float(b.x) + __uint_as_float(b.y);
}
__device__ __forceinline__ int mod_index(int row) { return row < R_P ? 0 : 1 + ((row - R_P) >> 11); }


#define XB_TMO      128
#define XB_XCNT(j)  (256  + 64 * (j))
#define XB_XSUB(j)  (1280 + 64 * (j))
#define XB_XGEN(j)  (2304 + 64 * (j))
#define XB_TOP      3328
#define XB_TOPGEN   3392
#define XCD_BAR_WORDS 3456
#define XB_SPIN_CAP (1u << 20)
__device__ __forceinline__ unsigned xb_ld(unsigned* p)              { return __hip_atomic_load(p, __ATOMIC_RELAXED, __HIP_MEMORY_SCOPE_AGENT); }
__device__ __forceinline__ unsigned xb_add(unsigned* p, unsigned v) { return __hip_atomic_fetch_add(p, v, __ATOMIC_RELAXED, __HIP_MEMORY_SCOPE_AGENT); }
__device__ __forceinline__ unsigned xb_xcc_id() { return (unsigned)__builtin_amdgcn_s_getreg((3 << 11) | 20) & 0xFu; }
#define XB_SPIN(cond, bar) do { unsigned _sp = 0; while (cond) { __builtin_amdgcn_s_sleep(1); \
    if ((++_sp & 255u) == 0u) { if (xb_ld(&(bar)[XB_TMO])) break; if (_sp > XB_SPIN_CAP) { atomicAdd(&(bar)[XB_TMO], 1u); break; } } } } while (0)
struct XcdBarrier { unsigned* bar; unsigned x; volatile LAS unsigned* st; };
__device__ __forceinline__ XcdBarrier xcd_barrier_post(unsigned* bar, volatile LAS unsigned* st) {
    XcdBarrier b; b.bar = bar; b.x = xb_xcc_id(); b.st = st;
    if (threadIdx.x == 0) (void)xb_add(&bar[XB_XCNT(b.x)], 1u);
    return b;
}
__device__ __forceinline__ void xcd_barrier_complete(unsigned* bar, unsigned x, unsigned& nloc, unsigned& nx) {
    const unsigned G = gridDim.x * gridDim.y * gridDim.z;
    unsigned sum, cnt, mine, sp = 0u;
    for (;;) {
        sum = 0u; cnt = 0u; mine = 0u;
#pragma unroll
        for (unsigned j = 0; j < 16; ++j) { const unsigned c = xb_ld(&bar[XB_XCNT(j)]); sum += c; cnt += (c > 0u) ? 1u : 0u; mine = (j == x) ? c : mine; }
        if (sum == G) break;
        __builtin_amdgcn_s_sleep(1);
        if ((++sp & 255u) == 0u) { if (xb_ld(&bar[XB_TMO])) break; if (sp > XB_SPIN_CAP) { atomicAdd(&bar[XB_TMO], 1u); break; } }
    }
    nloc = mine > 0u ? mine : 1u; nx = cnt > 0u ? cnt : 1u;
}
__device__ __forceinline__ void xcd_barrier(const XcdBarrier& b) {
    asm volatile("s_waitcnt vmcnt(0)" ::: "memory");
    __syncthreads();
    if (threadIdx.x == 0) {
        unsigned* bar = b.bar;
        __builtin_amdgcn_s_waitcnt(0);
        unsigned nloc = b.st[0], nx = b.st[1];
        if (nloc == 0u) { xcd_barrier_complete(bar, b.x, nloc, nx); b.st[0] = nloc; b.st[1] = nx; }
        const unsigned old = xb_add(&bar[XB_XSUB(b.x)], 1u);
        const unsigned gen = old / nloc;
        if (old + 1u == (gen + 1u) * nloc) {
            __builtin_amdgcn_fence(__ATOMIC_RELEASE, "agent");
            asm volatile("s_waitcnt vmcnt(0)" ::: "memory");
            const unsigned og = xb_add(&bar[XB_TOP], 1u);
            const unsigned tg = og / nx;
            if (og + 1u == (tg + 1u) * nx) xb_add(&bar[XB_TOPGEN], 1u);
            else XB_SPIN(xb_ld(&bar[XB_TOPGEN]) == tg, bar);
            __builtin_amdgcn_fence(__ATOMIC_ACQUIRE, "agent");
            xb_add(&bar[XB_XGEN(b.x)], 1u);
            asm volatile("s_waitcnt vmcnt(0)" ::: "memory");
        } else {
            XB_SPIN(xb_ld(&bar[XB_XGEN(b.x)]) == gen, bar);
            __builtin_amdgcn_fence(__ATOMIC_ACQUIRE, "agent");
            asm volatile("s_waitcnt vmcnt(0)" ::: "memory");
        }
    }
    __syncthreads();
}

namespace pg8 {
constexpr int BM = 256, BK = 64, HALF = 128, HTB = HALF * BK * 2, NXCD = 8, WGM = 4;
__device__ __forceinline__ int lds_byte(int r, int c) { const int st = (r >> 4) * 2 + (c >> 5), rr = r & 15, cc = c & 31, ob = rr * 64 + cc * 2; return st * 1024 + (ob ^ (((ob >> 9) & 1) << 5)); }
__device__ __forceinline__ void stage_rc(int b, int& R, int& C) { const int st = b / 1024, sb = b % 1024, swz = sb ^ (((sb >> 9) & 1) << 5); R = (st >> 1) * 16 + swz / 64; C = (st & 1) * 32 + (swz % 64) / 2; }
__device__ __forceinline__ int perm32(int rho) { const int n = rho >> 4, i = rho & 15; return 8 * (i >> 2) + 4 * n + (i & 3); }

struct Unit { const char* a; const char* b; int pm, pn; };

struct GridSrc {
    const char* A; const char* B; size_t tstepA, tstepB; int nM, nN, nwg, G, c;
    __device__ void init(const void* A_, int lda, const void* B_, int ldb, int M, int N, int G_, int c_, int bm = BM) {
        A = (const char*)A_; B = (const char*)B_; tstepA = (size_t)bm * lda * 2; tstepB = (size_t)BM * ldb * 2; nM = M / bm; nN = N / BM; nwg = nM * nN; G = G_; c = c_; }
    __device__ bool next(int i, Unit& u) const {
        const long L = (long)i * G + c; if (L >= nwg) return false;
        int wgid = (int)L; { const int q = nwg / NXCD, r = nwg % NXCD, xcd = wgid % NXCD, off = wgid / NXCD; wgid = (xcd < r ? xcd * (q + 1) : r * (q + 1) + (xcd - r) * q) + off; }
        const int nig = WGM * nN, gid = wgid / nig, fm = gid * WGM, gsz = (nM - fm) < WGM ? (nM - fm) : WGM;
        u.pm = fm + ((wgid % nig) % gsz); u.pn = (wgid % nig) / gsz;
        u.a = A + (size_t)u.pm * tstepA; u.b = B + (size_t)u.pn * tstepB; return true;
    }
};
struct OneSrc {
    Unit u0;
    __device__ bool next(int i, Unit& u) const { if (i != 0) return false; u = u0; return true; }
};

template <class Epi, class Src>
__device__ __forceinline__ void gemm_phase(LAS unsigned char* lds, const int lda, const int ldb, const int K, const Src& S, const Epi& E, const size_t kstepA = 128, const size_t kstepB = 128) {
    const int tid = threadIdx.x, wid = __builtin_amdgcn_readfirstlane(tid >> 6), lane = tid & 63, wr = wid >> 2, wc = wid & 3, fr = lane & 15, fq = lane >> 4;
    constexpr int MT = Epi::MT;
    const int nt = K / BK;
    unsigned voffA[2], voffB[2];
#pragma unroll
    for (int i = 0; i < 2; ++i) { int R, C; stage_rc(tid * 16 + i * 8192, R, C); const int Rb = Epi::PERM ? ((R & ~31) + perm32(R & 31)) : R;
        voffA[i] = (unsigned)(R * lda + C) * 2u; voffB[i] = (unsigned)(Rb * ldb + C) * 2u; }
    const size_t hstepA = (size_t)(MT * 32) * lda * 2, hstepB = (size_t)HALF * ldb * 2;
    const unsigned ldsw = (unsigned)wid * 1024u;
    const int aoff = lds_byte(wr * (MT * 16) + fr, fq * 8), boff = lds_byte(wc * 32 + fr, fq * 8);
#define PG8_SA(b, h) (((b) * 2 + (h)) * HTB)
#define PG8_SB(b, h) ((4 + (b) * 2 + (h)) * HTB)
#define PG8_STAGE(bufoff, gbase, voff) do { _Pragma("unroll") for (int _i = 0; _i < 2; ++_i) \
        __builtin_amdgcn_global_load_lds((const unsigned*)((const char*)(gbase) + (voff)[_i]), (LAS unsigned*)(lds + (bufoff) + ldsw + _i * 8192), 16, 0, 0); } while (0)
#define PG8_STAGE_A(bufoff, gbase) do { __builtin_amdgcn_global_load_lds((const unsigned*)((const char*)(gbase) + voffA[0]), (LAS unsigned*)(lds + (bufoff) + ldsw), 16, 0, 0); \
        if (MT == 4 || wr == 0) __builtin_amdgcn_global_load_lds((const unsigned*)((const char*)(gbase) + voffA[1]), (LAS unsigned*)(lds + (bufoff) + ldsw + 8192), 16, 0, 0); } while (0)
#define PG8_LDA(dst, b, h) do { _Pragma("unroll") for (int m = 0; m < MT; ++m) _Pragma("unroll") for (int k = 0; k < 2; ++k) dst[m][k] = *(const LAS bf16x8*)(lds + PG8_SA(b, h) + aoff + m * 2048 + k * 1024); } while (0)
#define PG8_LDB(dst, b, h) do { _Pragma("unroll") for (int n = 0; n < 2; ++n) _Pragma("unroll") for (int k = 0; k < 2; ++k) dst[n][k] = *(const LAS bf16x8*)(lds + PG8_SB(b, h) + boff + n * 2048 + k * 1024); } while (0)
#define PG8_MMA(ai, bj, At, Bt) do { __builtin_amdgcn_s_setprio(1); _Pragma("unroll") for (int m = 0; m < MT; ++m) _Pragma("unroll") for (int n = 0; n < 2; ++n) _Pragma("unroll") for (int k = 0; k < 2; ++k) \
        acc[ai][bj][m][n] = __builtin_amdgcn_mfma_f32_16x16x32_bf16(Bt[n][k], At[m][k], acc[ai][bj][m][n], 0, 0, 0); __builtin_amdgcn_s_setprio(0); } while (0)
#define PG8_WAIT_V(n) asm volatile("s_waitcnt vmcnt(" #n ")" ::: "memory")
#define PG8_WAIT_L(n) asm volatile("s_waitcnt lgkmcnt(" #n ")" ::: "memory")
#define PG8_BAR __builtin_amdgcn_s_barrier()
#define PG8_SCHED __builtin_amdgcn_sched_barrier(0)
    Unit cur, nxt; int ui = 0;
    if (!S.next(0, cur)) return;
    f32x4 acc[2][2][MT][2];
#pragma unroll
    for (int a = 0; a < 2; ++a)
#pragma unroll
        for (int b = 0; b < 2; ++b)
#pragma unroll
            for (int m = 0; m < MT; ++m)
#pragma unroll
                for (int n = 0; n < 2; ++n) acc[a][b][m][n] = (f32x4){0.f, 0.f, 0.f, 0.f};
    bf16x8 At[MT][2], B0[2][2], B1[2][2];
    const char* cA = cur.a; const char* cB = cur.b;
    PG8_STAGE(PG8_SB(0, 0), cB, voffB); PG8_STAGE_A(PG8_SA(0, 0), cA); PG8_STAGE(PG8_SB(0, 1), cB + hstepB, voffB); PG8_STAGE_A(PG8_SA(0, 1), cA + hstepA);
    if (wr == 1) PG8_BAR;
    if (MT == 3 && wr == 1) PG8_WAIT_V(3); else PG8_WAIT_V(4);
    PG8_BAR;
    PG8_STAGE(PG8_SB(1, 0), cB + kstepB, voffB); PG8_STAGE_A(PG8_SA(1, 0), cA + kstepA); PG8_STAGE(PG8_SB(1, 1), cB + hstepB + kstepB, voffB);
    if (MT == 3 && wr == 1) PG8_WAIT_V(5); else PG8_WAIT_V(6);
    PG8_BAR;
    for (;;) {
        const bool has_next = S.next(ui + 1, nxt);
        const char* nA = has_next ? nxt.a : cA; const char* nB = has_next ? nxt.b : cB;
        for (int t = 0; t < nt; t += 2) {
            const bool last = (t == nt - 2);
            const char* a1 = cA + (size_t)(t + 1) * kstepA;
            const char* a2 = last ? nA : cA + (size_t)(t + 2) * kstepA; const char* b2 = last ? nB : cB + (size_t)(t + 2) * kstepB;
            const char* a3 = a2 + kstepA; const char* b3 = b2 + kstepB;
            PG8_LDB(B0, 0, 0); PG8_SCHED; PG8_LDA(At, 0, 0); PG8_STAGE_A(PG8_SA(1, 1), a1 + hstepA);
            PG8_WAIT_L(8); PG8_BAR; PG8_WAIT_L(0); PG8_MMA(0, 0, At, B0); PG8_BAR; PG8_SCHED;
            PG8_LDB(B1, 0, 1); PG8_STAGE(PG8_SB(0, 0), b2, voffB);
            PG8_BAR; PG8_WAIT_L(0); PG8_MMA(0, 1, At, B1); PG8_BAR;
            PG8_LDA(At, 0, 1); PG8_STAGE_A(PG8_SA(0, 0), a2);
            PG8_BAR; PG8_WAIT_L(0); PG8_MMA(1, 0, At, B0); PG8_BAR; PG8_SCHED;
            PG8_STAGE(PG8_SB(0, 1), b2 + hstepB, voffB);
            if (MT == 3 && wr == 1) PG8_WAIT_V(5); else PG8_WAIT_V(6);
            PG8_BAR; PG8_MMA(1, 1, At, B1); PG8_BAR;
            PG8_LDB(B0, 1, 0); PG8_SCHED; PG8_LDA(At, 1, 0); PG8_STAGE_A(PG8_SA(0, 1), a2 + hstepA);
            PG8_WAIT_L(8); PG8_BAR; PG8_WAIT_L(0); PG8_MMA(0, 0, At, B0); PG8_BAR; PG8_SCHED;
            PG8_LDB(B1, 1, 1); PG8_STAGE(PG8_SB(1, 0), b3, voffB);
            PG8_BAR; PG8_WAIT_L(0); PG8_MMA(0, 1, At, B1); PG8_BAR;
            PG8_LDA(At, 1, 1); PG8_STAGE_A(PG8_SA(1, 0), a3);
            PG8_BAR; PG8_WAIT_L(0); PG8_MMA(1, 0, At, B0); PG8_BAR; PG8_SCHED;
            PG8_STAGE(PG8_SB(1, 1), b3 + hstepB, voffB);
            if (MT == 3 && wr == 1) PG8_WAIT_V(5); else PG8_WAIT_V(6);
            PG8_BAR; PG8_MMA(1, 1, At, B1); PG8_BAR;
        }
        E(acc, cur, wr, wc, fr, fq);
        if (!has_next) break;
#pragma unroll
        for (int a = 0; a < 2; ++a)
#pragma unroll
            for (int b = 0; b < 2; ++b)
#pragma unroll
                for (int m = 0; m < MT; ++m)
#pragma unroll
                    for (int n = 0; n < 2; ++n) acc[a][b][m][n] = (f32x4){0.f, 0.f, 0.f, 0.f};
        cur = nxt; cA = nA; cB = nB; ++ui;
    }
    PG8_WAIT_V(0);
    if (wr == 0) PG8_BAR;
    PG8_BAR;
#undef PG8_SA
#undef PG8_SB
#undef PG8_STAGE
#undef PG8_STAGE_A
#undef PG8_LDA
#undef PG8_LDB
#undef PG8_MMA
#undef PG8_WAIT_V
#undef PG8_WAIT_L
#undef PG8_BAR
#undef PG8_SCHED
}
}
using pg8::Unit;

struct EpiUp {
    static constexpr int MT = 3;
    static constexpr bool PERM = true;
    bf16_t* act;
    __device__ __forceinline__ void operator()(const f32x4 (&acc)[2][2][MT][2], const Unit& u, int wr, int wc, int fr, int fq) const {
        const int row0 = u.pm * (MT * 64) + wr * (MT * 16) + fr, col0 = u.pn * 128 + wc * 32 + 8 * fq;
#pragma unroll
        for (int ai = 0; ai < 2; ++ai)
#pragma unroll
            for (int m = 0; m < MT; ++m) {
                float o[8];
#pragma unroll
                for (int n = 0; n < 2; ++n)
#pragma unroll
                    for (int j = 0; j < 4; j += 2) { const f32x2 a = (f32x2){acc[ai][0][m][n][j], acc[ai][0][m][n][j + 1]}, b = (f32x2){acc[ai][1][m][n][j], acc[ai][1][m][n][j + 1]};
                        const f32x2 t = a * (-1.44269504089f); f32x2 e; e.x = __builtin_amdgcn_exp2f(t.x); e.y = __builtin_amdgcn_exp2f(t.y);
                        const f32x2 d = e + 1.0f; f32x2 r; r.x = __builtin_amdgcn_rcpf(d.x); r.y = __builtin_amdgcn_rcpf(d.y);
                        const f32x2 y = (a * r) * b; o[n * 4 + j] = y.x; o[n * 4 + j + 1] = y.y; }
                u32x4 w; w.x = cvt_pk_bf16(o[0], o[1]); w.y = cvt_pk_bf16(o[2], o[3]); w.z = cvt_pk_bf16(o[4], o[5]); w.w = cvt_pk_bf16(o[6], o[7]);
                *(u32x4*)(act + ((size_t)(u.pn * 2 + (wc >> 1)) * R_ALL + (row0 + ai * (MT * 32) + m * 16)) * 64 + (wc & 1) * 32 + 8 * fq) = w;
            }
    }
};
struct EpiRes {
    static constexpr int MT = 3;
    static constexpr bool PERM = false;
    float* X; const float* xin_p; const float* xin_s; const float* modl; int gchunk; float gs;
    __device__ __forceinline__ void operator()(const f32x4 (&acc)[2][2][MT][2], const Unit& u, int wr, int wc, int fr, int fq) const {
        const int row0 = u.pm * (MT * 64) + wr * (MT * 16) + fr, col0 = u.pn * 256 + wc * 32 + 4 * fq;
        f32x4 rv[2][MT][2][2];
#pragma unroll
        for (int ai = 0; ai < 2; ++ai)
#pragma unroll
            for (int m = 0; m < MT; ++m) { const int row = row0 + ai * (MT * 32) + m * 16;
                const float* rp = (xin_p ? (row < R_P ? xin_p + (size_t)row * DM : xin_s + (size_t)(row - R_P) * DM) : X + (size_t)row * DM) + col0;
#pragma unroll
                for (int bj = 0; bj < 2; ++bj)
#pragma unroll
                    for (int n = 0; n < 2; ++n) rv[ai][m][bj][n] = *(const f32x4*)(rp + bj * 128 + n * 16); }
        const int mi0 = mod_index(u.pm * (MT * 64)), mi1 = mod_index(u.pm * (MT * 64) + MT * 64 - 1);
        if (mi0 == mi1) {
            const float* gate = modl + (size_t)mi0 * 9216 + gchunk * 1024 + col0;
            f32x4 gv[2][2];
#pragma unroll
            for (int bj = 0; bj < 2; ++bj)
#pragma unroll
                for (int n = 0; n < 2; ++n) gv[bj][n] = *(const f32x4*)(gate + bj * 128 + n * 16) * gs;
#pragma unroll
            for (int ai = 0; ai < 2; ++ai)
#pragma unroll
                for (int m = 0; m < MT; ++m) { float* xp = X + (size_t)(row0 + ai * (MT * 32) + m * 16) * DM + col0;
#pragma unroll
                    for (int bj = 0; bj < 2; ++bj)
#pragma unroll
                        for (int n = 0; n < 2; ++n) *(f32x4*)(xp + bj * 128 + n * 16) = rv[ai][m][bj][n] + gv[bj][n] * acc[ai][bj][m][n]; }
        } else {
#pragma unroll
            for (int ai = 0; ai < 2; ++ai)
#pragma unroll
                for (int m = 0; m < MT; ++m) { const int row = row0 + ai * (MT * 32) + m * 16;
                    const float* gate = modl + (size_t)mod_index(row) * 9216 + gchunk * 1024 + col0; float* xp = X + (size_t)row * DM + col0;
#pragma unroll
                    for (int bj = 0; bj < 2; ++bj)
#pragma unroll
                        for (int n = 0; n < 2; ++n) { const f32x4 gv = *(const f32x4*)(gate + bj * 128 + n * 16);
                            *(f32x4*)(xp + bj * 128 + n * 16) = rv[ai][m][bj][n] + (gv * gs) * acc[ai][bj][m][n]; }
                    asm volatile("" ::: "memory"); }
        }
    }
};
struct EpiL0In {
    static constexpr int MT = 3;
    static constexpr bool PERM = false;
    bf16_t* P; float* LG;
    __device__ __forceinline__ void operator()(const f32x4 (&acc)[2][2][MT][2], const Unit& u, int wr, int wc, int fr, int fq) const {
        const int row0 = u.pm * (MT * 64) + wr * (MT * 16) + fr;
        if (u.pn < 6) {
            const int col0 = u.pn * 256 + wc * 32 + 4 * fq;
#pragma unroll
            for (int ai = 0; ai < 2; ++ai)
#pragma unroll
                for (int m = 0; m < MT; ++m) { bf16_t* pp = P + (size_t)(row0 + ai * (MT * 32) + m * 16) * 1536 + col0;
#pragma unroll
                    for (int bj = 0; bj < 2; ++bj)
#pragma unroll
                        for (int n = 0; n < 2; ++n) { const f32x4 v = acc[ai][bj][m][n]; u32x2 w; w.x = cvt_pk_bf16(v[0], v[1]); w.y = cvt_pk_bf16(v[2], v[3]); *(u32x2*)(pp + bj * 128 + n * 16) = w; } }
        } else if (wc == 0) {
#pragma unroll
            for (int ai = 0; ai < 2; ++ai)
#pragma unroll
                for (int m = 0; m < MT; ++m) { float* lp = LG + (size_t)(row0 + ai * (MT * 32) + m * 16) * 32 + 4 * fq;
#pragma unroll
                    for (int n = 0; n < 2; ++n) *(f32x4*)(lp + n * 16) = acc[ai][0][m][n]; }
        }
    }
};
struct EpiL0Z {
    static constexpr int MT = 4;
    static constexpr bool PERM = false;
    bf16_t* ZTS; bf16_t* ZTP;
    __device__ __forceinline__ void operator()(const f32x4 (&acc)[2][2][4][2], const Unit& u, int wr, int wc, int fr, int fq) const {
        const int part = u.pm >> 1, c0 = (u.pm & 1) * 256 + wr * 64 + fr;
        bf16_t* base; int ld;
        if (u.pn < 32) { base = ZTP + (size_t)u.pn * 512 * 512 + part * 256; ld = 512; }
        else { const int s = u.pn - 32; base = ZTS + (size_t)(s >> 3) * 512 * 4096 + part * 2048 + (s & 7) * 256; ld = 4096; }
        const int t0 = wc * 32 + 4 * fq;
#pragma unroll
        for (int ai = 0; ai < 2; ++ai)
#pragma unroll
            for (int m = 0; m < 4; ++m) { bf16_t* pp = base + (size_t)(c0 + ai * 128 + m * 16) * ld + t0;
#pragma unroll
                for (int bj = 0; bj < 2; ++bj)
#pragma unroll
                    for (int n = 0; n < 2; ++n) { const f32x4 v = acc[ai][bj][m][n]; u32x2 w; w.x = cvt_pk_bf16(v[0], v[1]); w.y = cvt_pk_bf16(v[2], v[3]); *(u32x2*)(pp + bj * 128 + n * 16) = w; } }
    }
};
struct EpiBf {
    static constexpr int MT = 4;
    static constexpr bool PERM = true;
    bf16_t* O; int ldc;
    __device__ __forceinline__ void operator()(const f32x4 (&acc)[2][2][4][2], const Unit& u, int wr, int wc, int fr, int fq) const {
        const int row0 = u.pm * 256 + wr * 64 + fr, col0 = u.pn * 256 + wc * 32 + 8 * fq;
#pragma unroll
        for (int ai = 0; ai < 2; ++ai)
#pragma unroll
            for (int m = 0; m < 4; ++m) { bf16_t* pp = O + (size_t)(row0 + ai * 128 + m * 16) * ldc + col0;
#pragma unroll
                for (int bj = 0; bj < 2; ++bj) { const f32x4 v0 = acc[ai][bj][m][0], v1 = acc[ai][bj][m][1];
                    u32x4 w; w.x = cvt_pk_bf16(v0[0], v0[1]); w.y = cvt_pk_bf16(v0[2], v0[3]); w.z = cvt_pk_bf16(v1[0], v1[1]); w.w = cvt_pk_bf16(v1[2], v1[3]);
                    *(u32x4*)(pp + bj * 128) = w; } }
    }
};
struct EpiQKV {
    static constexpr int MT = 3;
    static constexpr bool PERM = false;
    bf16_t* Q; bf16_t* Kb; bf16_t* Vb; float* kc; float* vc; const float* rope;
    __device__ __forceinline__ void operator()(const f32x4 (&acc)[2][2][MT][2], const Unit& u, int wr, int wc, int fr, int fq) const {
        const int row0 = u.pm * (MT * 64) + wr * (MT * 16) + fr;
        const float sc = u.pn < 4 ? 0.125f * 1.44269504089f : 1.0f;
#pragma unroll
        for (int ai = 0; ai < 2; ++ai)
#pragma unroll
            for (int m = 0; m < MT; ++m) {
                const int row = row0 + ai * (MT * 32) + m * 16; const bool samp = row >= R_P;
                f32x4 cs0 = (f32x4){1.f, 0.f, 1.f, 0.f}, cs1 = cs0;
                if (samp && u.pn < 5) { const int t = (row - R_P) & 2047; const float* rp = rope + ((size_t)t * 32 + (wc & 1) * 16 + 4 * fq) * 2; cs0 = *(const f32x4*)rp; cs1 = *(const f32x4*)(rp + 4); }
                const float cj[4] = {cs0[0], cs0[2], cs1[0], cs1[2]}, sj[4] = {cs0[1], cs0[3], cs1[1], cs1[3]};
#pragma unroll
                for (int bj = 0; bj < 2; ++bj) {
                    f32x4 v0 = acc[ai][bj][m][0] * sc, v1 = acc[ai][bj][m][1] * sc, o0, o1;
#pragma unroll
                    for (int j = 0; j < 4; ++j) { o0[j] = v0[j] * cj[j] - v1[j] * sj[j]; o1[j] = v1[j] * cj[j] + v0[j] * sj[j]; }
                    const int cl = bj * 128 + wc * 32 + 4 * fq;
                    u32x2 w0, w1; w0.x = cvt_pk_bf16(o0[0], o0[1]); w0.y = cvt_pk_bf16(o0[2], o0[3]); w1.x = cvt_pk_bf16(o1[0], o1[1]); w1.y = cvt_pk_bf16(o1[2], o1[3]);
                    if (u.pn < 4) { bf16_t* p = Q + (size_t)row * 1024 + u.pn * 256 + cl; *(u32x2*)p = w0; *(u32x2*)(p + 16) = w1; }
                    else if (u.pn == 4) { bf16_t* p = Kb + (size_t)row * 256 + cl; *(u32x2*)p = w0; *(u32x2*)(p + 16) = w1;
                        if (!samp) { float* f = kc + (size_t)row * 256 + cl; *(f32x4*)f = o0; *(f32x4*)(f + 16) = o1; } }
                    else { bf16_t* p = Vb + (size_t)row * 256 + cl; *(u32x2*)p = w0; *(u32x2*)(p + 16) = w1;
                        if (!samp) { float* f = vc + (size_t)row * 256 + cl; *(f32x4*)f = o0; *(f32x4*)(f + 16) = o1; } }
                }
            }
    }
};

__device__ __forceinline__ void transpose_tile(LAS float* tl, const float* src, int sld, int scol0, int k0, bf16_t* dst, int nrows, int drow0, int nvalid) {
    const int tid = threadIdx.x;
    { const int c4 = (tid & 15) * 4, kk = tid >> 4; f32x4 v[8];
#pragma unroll
      for (int h = 0; h < 8; ++h) { v[h] = (f32x4){0.f, 0.f, 0.f, 0.f}; if (c4 < nvalid) v[h] = __builtin_nontemporal_load((const f32x4*)(src + (size_t)(k0 + kk + h * 32) * sld + scol0 + c4)); }
#pragma unroll
      for (int h = 0; h < 8; ++h) { const int k = kk + h * 32; tl[k * 65 + c4] = v[h][0]; tl[k * 65 + c4 + 1] = v[h][1]; tl[k * 65 + c4 + 2] = v[h][2]; tl[k * 65 + c4 + 3] = v[h][3]; } }
    __syncthreads();
    { const int c = tid >> 3, kc = (tid & 7) * 8;
#pragma unroll
      for (int h = 0; h < 4; ++h) { float v[8];
#pragma unroll
          for (int e = 0; e < 8; ++e) v[e] = tl[(h * 64 + kc + e) * 65 + c];
          u32x4 w; w.x = cvt_pk_bf16(v[0], v[1]); w.y = cvt_pk_bf16(v[2], v[3]); w.z = cvt_pk_bf16(v[4], v[5]); w.w = cvt_pk_bf16(v[6], v[7]);
          *(u32x4*)(dst + ((size_t)((k0 >> 6) + h) * nrows + drow0 + c) * 64 + kc) = w; } }
    __syncthreads();
}

__device__ __forceinline__ void prep_transposes(const Params& p, LAS unsigned char* lds, bool late, int rank, int nrank) {
    unsigned char* ws = p.ws; LAS float* tl = (LAS float*)lds;
    constexpr int UPI = 88 * 4, DNI = 16 * 11;
    const int nup = late ? 3 * UPI : UPI, ndn = late ? 3 * DNI : DNI, nin = late ? 24 * 4 : 28 * 4, nsq = 16 * 4;
    const int T0 = nup, T1 = T0 + ndn, T2 = T1 + nin, T3 = T2 + nsq;
    for (int it = rank; it < T3; it += nrank) {
        if (it < T0) { const int li = (late ? 1 : 0) + it / UPI, r = it % UPI, jt = r / 4, kt = r % 4;
            const int pn = jt >> 2, bj = (jt >> 1) & 1, hh = jt & 1;
            const float* src = (bj ? p.ffn_w3 : p.ffn_w1) + (size_t)li * DM * FF;
            transpose_tile(tl, src, FF, pn * 128 + hh * 64, kt * 256, (bf16_t*)(ws + WS_WUP) + (size_t)li * 5632 * 1024, 5632, jt * 64, 64);
        } else if (it < T1) { const int q = it - T0, li = (late ? 1 : 0) + q / DNI, r = q % DNI, jt = r / 11, kt = r % 11;
            transpose_tile(tl, p.ffn_w2 + (size_t)li * FF * DM, DM, jt * 64, kt * 256, (bf16_t*)(ws + WS_WDN) + (size_t)li * 1024 * 2816, 1024, jt * 64, 64);
        } else if (it < T2) { const int q = it - T1, jt = q / 4, kt = q % 4;
            if (late) transpose_tile(tl, p.l1_w_in, 1536, jt * 64, kt * 256, (bf16_t*)(ws + WS_WL1IN), 1536, jt * 64, 64);
            else { const int nv = 1568 - jt * 64; transpose_tile(tl, p.l0_w_in, 2080, jt * 64, kt * 256, (bf16_t*)(ws + WS_WL0IN), 1792, jt * 64, nv < 0 ? 0 : (nv > 64 ? 64 : nv)); }
        } else { const int q = it - T2, jt = q / 4, kt = q % 4;
            if (late) transpose_tile(tl, p.l1_w_out, 1024, jt * 64, kt * 256, (bf16_t*)(ws + WS_WL1O), 1024, jt * 64, 64);
            else transpose_tile(tl, p.l0_w_out, 1024, jt * 64, kt * 256, (bf16_t*)(ws + WS_WL0O), 1024, jt * 64, 64);
        }
    }
}

__device__ __forceinline__ void prep_modgemv(const Params& p, LAS unsigned char* lds, int it_lo, int it_hi, int rank, int nrank) {
    const int tid = threadIdx.x; unsigned char* ws = p.ws;
    {
        LAS float* sc = (LAS float*)lds;
        LAS float* red = sc + 9 * 1024;
        bool loaded = false;
        for (int it = it_lo + rank; it < it_hi; it += nrank) {
            if (!loaded) { for (int i = tid; i < 9 * 1024; i += NTHR) { const float v = i < 1024 ? p.c_ctx[i] : p.c[i - 1024]; sc[i] = siluf(v); } loaded = true; __syncthreads(); }
            const int l = it / 144, r = it % 144, cg = r >> 2, ks = r & 3, w = tid >> 6, lane = tid & 63;
            const int k0 = ks * 256 + w * 32;
            const float* wp = p.mod_w + (size_t)l * DM * 9216 + (size_t)k0 * 9216 + cg * 256 + lane * 4;
            f32x4 a[9];
#pragma unroll
            for (int m = 0; m < 9; ++m) a[m] = (f32x4){0.f, 0.f, 0.f, 0.f};
#pragma unroll 8
            for (int k = 0; k < 32; ++k) { const f32x4 wv = __builtin_nontemporal_load((const f32x4*)(wp + (size_t)k * 9216));
#pragma unroll
                for (int m = 0; m < 9; ++m) a[m] += wv * sc[m * 1024 + k0 + k]; }
#pragma unroll
            for (int m = 0; m < 9; ++m) *(LAS f32x4*)(red + (w * 9 + m) * 256 + lane * 4) = a[m];
            __syncthreads();
            for (int o = tid; o < 9 * 256; o += NTHR) { const int m = o >> 8, c = o & 255; float s = ks == 0 ? p.mod_b[l * 9216 + cg * 256 + c] : 0.f;
#pragma unroll
                for (int w2 = 0; w2 < 8; ++w2) s += red[(w2 * 9 + m) * 256 + c];
                unsafeAtomicAdd((float*)(ws + WS_MOD) + ((size_t)l * 9 + m) * 9216 + cg * 256 + c, s); }
            __syncthreads();
        }
        __syncthreads();
    }
}

__device__ __forceinline__ void phase_prep(const Params& p, LAS unsigned char* lds) {
    const int tid = threadIdx.x, G = gridDim.x, bid = blockIdx.x;
    unsigned char* ws = p.ws;
    prep_transposes(p, lds, false, bid, G);
    prep_modgemv(p, lds, 0, 144, bid, G);
    {
        const size_t gt = (size_t)bid * NTHR + tid, gn = (size_t)G * NTHR;
        bf16_t* dms = (bf16_t*)(ws + WS_DMS); bf16_t* dmp = (bf16_t*)(ws + WS_DMP);
        for (size_t i = gt; i < (size_t)2048 * 2048 / 2; i += gn) { const int t = (int)(i / 1024), k = (int)(i % 1024) * 2; float vc[2], vs[2];
#pragma unroll
            for (int e = 0; e < 2; ++e) { const int j = (t * (k + e)) & 2047; float sn, cs; sincospif((float)j * (1.0f / 1024.0f), &sn, &cs); vc[e] = cs * 0.02209708691f; vs[e] = -sn * 0.02209708691f; }
            *(unsigned*)(dms + (size_t)t * 4096 + k) = cvt_pk_bf16(vc[0], vc[1]); *(unsigned*)(dms + (size_t)t * 4096 + 2048 + k) = cvt_pk_bf16(vs[0], vs[1]); }
        for (size_t i = gt; i < (size_t)256 * 256 / 2; i += gn) { const int t = (int)(i / 128), k = (int)(i % 128) * 2; float vc[2], vs[2];
#pragma unroll
            for (int e = 0; e < 2; ++e) { const int j = (t * (k + e)) & 255; float sn, cs; sincospif((float)j * (1.0f / 128.0f), &sn, &cs); vc[e] = cs * 0.0625f; vs[e] = -sn * 0.0625f; }
            *(unsigned*)(dmp + (size_t)t * 512 + k) = cvt_pk_bf16(vc[0], vc[1]); *(unsigned*)(dmp + (size_t)t * 512 + 256 + k) = cvt_pk_bf16(vs[0], vs[1]); }
        for (size_t i = gt; i < (size_t)2048 * 32; i += gn) { const int t = (int)(i >> 5), e = (int)(i & 31), fi = e & 15;
            const float inv = powf(10000.0f, -(float)fi / 16.0f); const float pos = (float)((e < 16) ? (t >> 6) : (t & 63)); const float ang = pos * inv;
            float sn, cs; sincosf(ang, &sn, &cs); ((f32x2*)(ws + WS_ROPE))[i] = (f32x2){cs, sn}; }
        for (size_t i = gt; i < (size_t)2048 * 256 / 4; i += gn) {
            const f32x4 kv = ((const f32x4*)p.cache_k)[i], vv = ((const f32x4*)p.cache_v)[i]; u32x2 a, b;
            a.x = cvt_pk_bf16(kv[0], kv[1]); a.y = cvt_pk_bf16(kv[2], kv[3]); b.x = cvt_pk_bf16(vv[0], vv[1]); b.y = cvt_pk_bf16(vv[2], vv[3]);
            ((u32x2*)(ws + WS_CTXK))[i] = a; ((u32x2*)(ws + WS_CTXV))[i] = b; }
    }
    {
        LAS float* wu = (LAS float*)lds;
        LAS float* ct = wu + 64 * 129;
        LAS float* st = ct + 128;
        for (int it = bid; it < 256; it += G) {
            const int g = it >> 6, kb = ((it >> 2) & 15) * 64, cq = it & 3;
            __syncthreads();
            if (tid < 128) { const float a = (float)tid * (1.0f / 64.0f); ct[tid] = cospif(a) * 0.08838834765f; st[tid] = sinpif(a) * 0.08838834765f; }
            for (int i = tid; i < 64 * 32; i += NTHR) { const int k = i >> 5, c4 = (i & 31) * 4; const f32x4 v = *(const f32x4*)(p.l0_w_in + (size_t)(kb + k) * 2080 + 1568 + g * 128 + c4);
                wu[k * 129 + c4] = v[0]; wu[k * 129 + c4 + 1] = v[1]; wu[k * 129 + c4 + 2] = v[2]; wu[k * 129 + c4 + 3] = v[3]; }
            __syncthreads();
            const int k = tid & 63, w = tid >> 6;
            bf16_t* wz = (bf16_t*)(ws + WS_WL0Z);
            for (int cc = 0; cc < 4; ++cc) { const int c = cq * 32 + w * 4 + cc; float ac = 0.f, as = 0.f;
                for (int c2 = 0; c2 < 128; ++c2) { const float wv = wu[k * 129 + c2]; const int j = (c * c2) & 127; ac += wv * ct[j]; as += wv * st[j]; }
                const size_t kb_ = (size_t)((kb + k) >> 6) * 1024, ko = (size_t)((kb + k) & 63);
                wz[(kb_ + g * 128 + c) * 64 + ko] = f2bf(ac); wz[(kb_ + 512 + g * 128 + c) * 64 + ko] = f2bf(as); }
        }
        __syncthreads();
    }
}

__device__ __forceinline__ void phase_norm(const Params& p, const float* xsrc_p, const float* xsrc_s, const float* g, const float* modl, int shift_chunk) {
    bf16_t* H = (bf16_t*)(p.ws + WS_H);
    const int lane = threadIdx.x & 63, gw = blockIdx.x * 8 + (threadIdx.x >> 6), nw = gridDim.x * 8;
    f32x4 gg[4];
#pragma unroll
    for (int i = 0; i < 4; ++i) gg[i] = *(const f32x4*)(g + i * 256 + lane * 4);
    for (int row = gw; row < R_ALL; row += 2 * nw) {
        int rj[2]; f32x4 v[2][4], sh[2][4], sc[2][4];
#pragma unroll
        for (int j = 0; j < 2; ++j) { rj[j] = row + j * nw < R_ALL ? row + j * nw : row;
            const float* xr = rj[j] < R_P ? xsrc_p + (size_t)rj[j] * DM : xsrc_s + (size_t)(rj[j] - R_P) * DM;
#pragma unroll
            for (int i = 0; i < 4; ++i) v[j][i] = *(const f32x4*)(xr + i * 256 + lane * 4); }
#pragma unroll
        for (int j = 0; j < 2; ++j) { const float* md = modl + (size_t)mod_index(rj[j]) * 9216 + shift_chunk * 1024;
#pragma unroll
            for (int i = 0; i < 4; ++i) { sh[j][i] = *(const f32x4*)(md + i * 256 + lane * 4); sc[j][i] = *(const f32x4*)(md + 1024 + i * 256 + lane * 4); } }
#pragma unroll
        for (int j = 0; j < 2; ++j) { float ss = 0.f;
#pragma unroll
            for (int i = 0; i < 4; ++i) ss += v[j][i][0] * v[j][i][0] + v[j][i][1] * v[j][i][1] + v[j][i][2] * v[j][i][2] + v[j][i][3] * v[j][i][3];
#pragma unroll
            for (int o = 32; o >= 1; o >>= 1) ss += __shfl_xor(ss, o);
            const float rinv = rsqrtf(ss * (1.0f / 1024.0f) + EPS);
            if (j == 0 || row + j * nw < R_ALL) {
#pragma unroll
                for (int i = 0; i < 4; ++i) { const int c = i * 256 + lane * 4;
                    const f32x4 y = (v[j][i] * rinv) * gg[i] * (sc[j][i] + 1.0f) + sh[j][i]; u32x2 w; w.x = cvt_pk_bf16(y[0], y[1]); w.y = cvt_pk_bf16(y[2], y[3]);
                    *(u32x2*)(H + ((size_t)(c >> 6) * R_ALL + rj[j]) * 64 + (c & 63)) = w; } } }
    }
}
__device__ __forceinline__ void phase_final_norm(const Params& p) {
    const int lane = threadIdx.x & 63, gw = blockIdx.x * 8 + (threadIdx.x >> 6), nw = gridDim.x * 8;
    f32x4 gg[4];
#pragma unroll
    for (int i = 0; i < 4; ++i) gg[i] = *(const f32x4*)(p.final_g + i * 256 + lane * 4);
    for (int row = gw; row < R_ALL; row += 4 * nw) {
        f32x4 v[4][4];
#pragma unroll
        for (int j = 0; j < 4; ++j) { const int r = row + j * nw < R_ALL ? row + j * nw : row; const float* xr = p.out + (size_t)r * DM;
#pragma unroll
            for (int i = 0; i < 4; ++i) v[j][i] = *(const f32x4*)(xr + i * 256 + lane * 4); }
#pragma unroll
        for (int j = 0; j < 4; ++j) { float ss = 0.f;
#pragma unroll
            for (int i = 0; i < 4; ++i) ss += v[j][i][0] * v[j][i][0] + v[j][i][1] * v[j][i][1] + v[j][i][2] * v[j][i][2] + v[j][i][3] * v[j][i][3];
#pragma unroll
            for (int o = 32; o >= 1; o >>= 1) ss += __shfl_xor(ss, o);
            const float rinv = rsqrtf(ss * (1.0f / 1024.0f) + EPS);
            if (row + j * nw < R_ALL) { float* xr = p.out + (size_t)(row + j * nw) * DM;
#pragma unroll
                for (int i = 0; i < 4; ++i) *(f32x4*)(xr + i * 256 + lane * 4) = (v[j][i] * rinv) * gg[i]; } }
    }
}

__device__ __forceinline__ bf16x8 lds_b8(const LAS bf16_t* p) { return *(const LAS bf16x8*)p; }
__device__ __forceinline__ void gla_unit(const Params& p, LAS unsigned char* lds, bool samp, int uidx) {
    constexpr int PT = 72;
    LAS bf16_t* Qd = (LAS bf16_t*)lds;
    LAS bf16_t* Ki = Qd + 64 * PT;
    LAS bf16_t* KeT = Ki + 64 * PT;
    LAS bf16_t* AT = KeT + 64 * PT;
    LAS bf16_t* VT = AT + 64 * PT;
    LAS bf16_t* ST = VT + 128 * PT;
    LAS float* LGs = (LAS float*)(ST + 128 * PT);
    LAS float* wg = LGs + 64 * 16;
    LAS float* bg = wg + 16 * 64;
    LAS float* tot = bg + 64;
    LAS float* dec = tot + 8 * 64;
    LAS float* Zs = dec + 64;
    const int tid = threadIdx.x, wv = tid >> 6, lane = tid & 63, l15 = lane & 15, quad = lane >> 4;
    const int b = uidx >> 3, h = (uidx >> 1) & 3, dir = uidx & 1;
    const int T = samp ? 2048 : 256, row0 = samp ? R_P + b * 2048 : b * 256, NC = T / 64;
    const bf16_t* P = (const bf16_t*)(p.ws + WS_P); const float* LG = (const float*)(p.ws + WS_LG);
    bf16_t* Od = dir ? (bf16_t*)(p.ws + WS_OB) : (bf16_t*)(p.ws + WS_H); const int old = dir ? 512 : 1024;
    __syncthreads();
    float bgr;
    { const float* wsrc = dir ? p.l0_w_gb : p.l0_w_gf; const float* bsrc = dir ? p.l0_b_gb : p.l0_b_gf;
      for (int i = tid; i < 1024; i += NTHR) wg[i] = wsrc[(i >> 6) * 256 + h * 64 + (i & 63)];
      bgr = bsrc[h * 64 + (tid & 63)]; }
    f32x4 S[4];
    { const float* s0 = samp ? (dir ? p.st_b : p.st_f) + (size_t)(b * 4 + h) * 64 * 128 : nullptr;
#pragma unroll
      for (int kt = 0; kt < 4; ++kt) {
#pragma unroll
          for (int r = 0; r < 4; ++r) S[kt][r] = s0 ? s0[(size_t)(kt * 16 + quad * 4 + r) * 128 + wv * 16 + l15] : 0.f;
          u32x2 w; w.x = cvt_pk_bf16(S[kt][0], S[kt][1]); w.y = cvt_pk_bf16(S[kt][2], S[kt][3]);
          *(LAS u32x2*)(ST + (wv * 16 + l15) * PT + kt * 16 + quad * 4) = w; } }
    const int dk = tid & 63, tg = wv;
    unsigned short rq[8], rk[8]; unsigned rv[8]; f32x4 rlg = (f32x4){0.f, 0.f, 0.f, 0.f};
#define GLA_PREFETCH(c_) do { \
        _Pragma("unroll") for (int e = 0; e < 8; ++e) { const int pos = (c_) * 64 + tg * 8 + e; const size_t r = (size_t)(row0 + (dir ? T - 1 - pos : pos)); \
            rq[e] = P[r * 1536 + h * 64 + dk]; rk[e] = P[r * 1536 + 256 + h * 64 + dk]; } \
        if (tid < 256) { const int pos = (c_) * 64 + (tid >> 2); const size_t r = (size_t)(row0 + (dir ? T - 1 - pos : pos)); rlg = *(const f32x4*)(LG + r * 32 + dir * 16 + (tid & 3) * 4); } \
        { const int dv = tid & 127, sg = tid >> 7; \
          _Pragma("unroll") for (int e2 = 0; e2 < 8; ++e2) { const int pos0 = (c_) * 64 + sg * 16 + e2 * 2; const size_t r0 = (size_t)(row0 + (dir ? T - 1 - pos0 : pos0)), r1 = (size_t)(row0 + (dir ? T - 2 - pos0 : pos0 + 1)); \
              const unsigned a_ = P[r0 * 1536 + 512 + h * 128 + dv], b_ = P[r1 * 1536 + 512 + h * 128 + dv]; rv[e2] = a_ | (b_ << 16); } } } while (0)
    GLA_PREFETCH(0);
    for (int c = 0; c < NC; ++c) {
        float qv[8], kv[8];
#pragma unroll
        for (int e = 0; e < 8; ++e) { qv[e] = bf2f(rq[e]); kv[e] = bf2f(rk[e]); }
        if (tid < 256) *(LAS f32x4*)(LGs + (tid >> 2) * 16 + (tid & 3) * 4) = rlg;
        { const int dv = tid & 127, sg = tid >> 7;
          *(LAS u32x4*)(VT + dv * PT + sg * 16) = (u32x4){rv[0], rv[1], rv[2], rv[3]}; *(LAS u32x4*)(VT + dv * PT + sg * 16 + 8) = (u32x4){rv[4], rv[5], rv[6], rv[7]}; }
        __syncthreads();
        if (c + 1 < NC) GLA_PREFETCH(c + 1);
        { const int ti = wv >> 1;
#pragma unroll
          for (int d2 = 0; d2 < 2; ++d2) { const int di = (wv & 1) * 2 + d2; f32x4 a = (f32x4){0.f, 0.f, 0.f, 0.f};
#pragma unroll
              for (int kk = 0; kk < 4; ++kk) a = __builtin_amdgcn_mfma_f32_16x16x4f32(LGs[(ti * 16 + l15) * 16 + kk * 4 + quad], wg[(kk * 4 + quad) * 64 + di * 16 + l15], a, 0, 0, 0);
              *(LAS f32x4*)(Zs + (di * 16 + l15) * 68 + ti * 16 + quad * 4) = a; } }
        __syncthreads();
        float la[8], run = 0.f;
        const f32x4 z0 = *(const LAS f32x4*)(Zs + dk * 68 + tg * 8), z1 = *(const LAS f32x4*)(Zs + dk * 68 + tg * 8 + 4);
#pragma unroll
        for (int e = 0; e < 8; ++e) { const float z = (e < 4 ? z0[e] : z1[e - 4]) + bgr;
            const float ls = fminf(z, 0.f) - __logf(1.0f + __expf(-fabsf(z)));
            run += ls * (1.0f / 16.0f); la[e] = run; }
        tot[tg * 64 + dk] = run;
        __syncthreads();
        float off = 0.f, blast = 0.f;
#pragma unroll
        for (int g2 = 0; g2 < 8; ++g2) { const float tv = tot[g2 * 64 + dk]; blast += tv; off += (g2 < tg) ? tv : 0.f; }
        { unsigned kw[4];
          const float ebl = __expf(blast);
#pragma unroll
          for (int e = 0; e < 8; e += 2) { const float b0 = off + la[e], b1 = off + la[e + 1];
              const float e0 = __expf(b0), e1 = __expf(b1), i0 = __expf(-b0), i1 = __expf(-b1);
              Qd[(tg * 8 + e) * PT + dk] = f2bf(qv[e] * 0.125f * e0); Qd[(tg * 8 + e + 1) * PT + dk] = f2bf(qv[e + 1] * 0.125f * e1);
              const float k0 = kv[e] * i0, k1 = kv[e + 1] * i1;
              Ki[(tg * 8 + e) * PT + dk] = f2bf(k0); Ki[(tg * 8 + e + 1) * PT + dk] = f2bf(k1);
              kw[e >> 1] = cvt_pk_bf16(k0 * ebl, k1 * ebl); }
          *(LAS u32x4*)(KeT + dk * PT + tg * 8) = (u32x4){kw[0], kw[1], kw[2], kw[3]};
          if (tg == 0) dec[dk] = ebl; }
        __syncthreads();
        { const int ti = wv >> 1;
#pragma unroll
          for (int s2 = 0; s2 < 2; ++s2) { const int sj = (wv & 1) * 2 + s2; f32x4 a = (f32x4){0.f, 0.f, 0.f, 0.f};
#pragma unroll
              for (int kk = 0; kk < 2; ++kk) a = __builtin_amdgcn_mfma_f32_16x16x32_bf16(lds_b8(Qd + (ti * 16 + l15) * PT + kk * 32 + quad * 8), lds_b8(Ki + (sj * 16 + l15) * PT + kk * 32 + quad * 8), a, 0, 0, 0);
#pragma unroll
              for (int r = 0; r < 4; ++r) { const int t = ti * 16 + quad * 4 + r, s = sj * 16 + l15; AT[t * PT + s] = f2bf(s <= t ? a[r] : 0.f); } } }
        __syncthreads();
#pragma unroll
        for (int ti = 0; ti < 4; ++ti) { f32x4 a = (f32x4){0.f, 0.f, 0.f, 0.f};
#pragma unroll
            for (int kk = 0; kk < 2; ++kk) a = __builtin_amdgcn_mfma_f32_16x16x32_bf16(lds_b8(VT + (wv * 16 + l15) * PT + kk * 32 + quad * 8), lds_b8(AT + (ti * 16 + l15) * PT + kk * 32 + quad * 8), a, 0, 0, 0);
#pragma unroll
            for (int kk = 0; kk < 2; ++kk) a = __builtin_amdgcn_mfma_f32_16x16x32_bf16(lds_b8(ST + (wv * 16 + l15) * PT + kk * 32 + quad * 8), lds_b8(Qd + (ti * 16 + l15) * PT + kk * 32 + quad * 8), a, 0, 0, 0);
            const int pos = c * 64 + ti * 16 + l15; const size_t r = (size_t)(row0 + (dir ? T - 1 - pos : pos));
            u32x2 w; w.x = cvt_pk_bf16(a[0], a[1]); w.y = cvt_pk_bf16(a[2], a[3]);
            *(u32x2*)(Od + r * old + h * 128 + wv * 16 + quad * 4) = w; }
#pragma unroll
        for (int kt = 0; kt < 4; ++kt) {
#pragma unroll
            for (int r = 0; r < 4; ++r) S[kt][r] *= dec[kt * 16 + quad * 4 + r];
#pragma unroll
            for (int kk = 0; kk < 2; ++kk) S[kt] = __builtin_amdgcn_mfma_f32_16x16x32_bf16(lds_b8(KeT + (kt * 16 + l15) * PT + kk * 32 + quad * 8), lds_b8(VT + (wv * 16 + l15) * PT + kk * 32 + quad * 8), S[kt], 0, 0, 0);
            u32x2 w; w.x = cvt_pk_bf16(S[kt][0], S[kt][1]); w.y = cvt_pk_bf16(S[kt][2], S[kt][3]);
            *(LAS u32x2*)(ST + (wv * 16 + l15) * PT + kt * 16 + quad * 4) = w; }
        __syncthreads();
    }
    if (!samp) { float* so = p.out + (dir ? OUT_SB : OUT_SF) + (size_t)(b * 4 + h) * 64 * 128;
#pragma unroll
        for (int kt = 0; kt < 4; ++kt)
#pragma unroll
            for (int r = 0; r < 4; ++r) so[(size_t)(kt * 16 + quad * 4 + r) * 128 + wv * 16 + l15] = S[kt][r]; }
}

__device__ __forceinline__ void dft_unit(const Params& p, LAS unsigned char* lds, bool samp, int uidx) {
    pg8::OneSrc S; EpiBf E;
    if (samp) { const int b = uidx >> 4, pm = (uidx >> 1) & 7, pn = uidx & 1;
        S.u0.a = (const char*)(p.ws + WS_DMS) + (size_t)pm * 256 * 4096 * 2; S.u0.b = (const char*)(p.ws + WS_ZTS) + ((size_t)b * 512 + pn * 256) * 4096 * 2; S.u0.pm = pm; S.u0.pn = pn;
        E.O = (bf16_t*)(p.ws + WS_H) + (size_t)(R_P + b * 2048) * 1024 + 512; E.ldc = 1024;
        pg8::gemm_phase(lds, 4096, 4096, 4096, S, E);
    } else { const int b = uidx >> 1, pn = uidx & 1;
        S.u0.a = (const char*)(p.ws + WS_DMP); S.u0.b = (const char*)(p.ws + WS_ZTP) + ((size_t)b * 512 + pn * 256) * 512 * 2; S.u0.pm = 0; S.u0.pn = pn;
        E.O = (bf16_t*)(p.ws + WS_H) + (size_t)(b * 256) * 1024 + 512; E.ldc = 1024;
        pg8::gemm_phase(lds, 512, 512, 512, S, E);
    }
}

__device__ __forceinline__ void phase_combine(const Params& p) {
    const int lane = threadIdx.x & 63, gw = blockIdx.x * 8 + (threadIdx.x >> 6), nw = gridDim.x * 8;
    bf16_t* MIX = (bf16_t*)(p.ws + WS_H); const bf16_t* OB = (const bf16_t*)(p.ws + WS_OB); const bf16_t* P = (const bf16_t*)(p.ws + WS_P);
    const int c0 = lane * 8;
    f32x4 g0 = *(const f32x4*)(p.l0_g_head + (c0 & 127)), g1 = *(const f32x4*)(p.l0_g_head + (c0 & 127) + 4);
    for (int row0 = gw; row0 < R_ALL; row0 += 4 * nw) {
        u32x4 av[4], bv[4], ov[4];
#pragma unroll
        for (int j = 0; j < 4; ++j) { const int r = row0 + j * nw < R_ALL ? row0 + j * nw : row0;
            av[j] = *(const u32x4*)(MIX + (size_t)r * 1024 + c0); bv[j] = *(const u32x4*)(OB + (size_t)r * 512 + c0); ov[j] = *(const u32x4*)(P + (size_t)r * 1536 + 1024 + c0); }
#pragma unroll
        for (int j = 0; j < 4; ++j) { const int row = row0 + j * nw; const u32x4 a = av[j], bq = bv[j], og = ov[j];
        float o[8], gv[8];
        o[0] = bflo(a.x) + bflo(bq.x); o[1] = bfhi(a.x) + bfhi(bq.x); o[2] = bflo(a.y) + bflo(bq.y); o[3] = bfhi(a.y) + bfhi(bq.y);
        o[4] = bflo(a.z) + bflo(bq.z); o[5] = bfhi(a.z) + bfhi(bq.z); o[6] = bflo(a.w) + bflo(bq.w); o[7] = bfhi(a.w) + bfhi(bq.w);
        gv[0] = bflo(og.x); gv[1] = bfhi(og.x); gv[2] = bflo(og.y); gv[3] = bfhi(og.y); gv[4] = bflo(og.z); gv[5] = bfhi(og.z); gv[6] = bflo(og.w); gv[7] = bfhi(og.w);
        float ss = 0.f;
#pragma unroll
        for (int e = 0; e < 8; ++e) ss += o[e] * o[e];
#pragma unroll
        for (int s = 8; s >= 1; s >>= 1) ss += __shfl_xor(ss, s);
        const float rinv = rsqrtf(ss * (1.0f / 128.0f) + EPS);
        float y[8];
#pragma unroll
        for (int e = 0; e < 8; ++e) y[e] = o[e] * rinv * (e < 4 ? g0[e] : g1[e - 4]) * siluf(gv[e]);
        u32x4 w; w.x = cvt_pk_bf16(y[0], y[1]); w.y = cvt_pk_bf16(y[2], y[3]); w.z = cvt_pk_bf16(y[4], y[5]); w.w = cvt_pk_bf16(y[6], y[7]);
        if (row < R_ALL) *(u32x4*)(MIX + (size_t)row * 1024 + c0) = w; }
    }
}

__device__ __forceinline__ void attn_unit(const Params& p, LAS unsigned char* lds, int u) {
    constexpr int PT = 72;
    LAS bf16_t* Ks = (LAS bf16_t*)lds;
    LAS bf16_t* VTs = Ks + 64 * PT;
    const int tid = threadIdx.x, wv = tid >> 6, lane = tid & 63, l15 = lane & 15, quad = lane >> 4;
    const bf16_t* Qb = (const bf16_t*)(p.ws + WS_Q); const bf16_t* Kb = (const bf16_t*)(p.ws + WS_K); const bf16_t* Vb = (const bf16_t*)(p.ws + WS_V);
    const bf16_t* CK = (const bf16_t*)(p.ws + WS_CTXK); const bf16_t* CV = (const bf16_t*)(p.ws + WS_CTXV);
    bf16_t* Ob = (bf16_t*)(p.ws + WS_H);
    bool samp; int b, kvh, qb, row0, seq0;
    if (u < 512) { samp = true; b = u >> 6; kvh = (u >> 4) & 3; qb = u & 15; seq0 = R_P + b * 2048; row0 = seq0 + qb * 128; }
    else { const int v = u - 512; samp = false; b = v >> 3; kvh = (v >> 1) & 3; qb = v & 1; seq0 = b * 256; row0 = seq0 + qb * 128; }
    const int qrow = row0 + wv * 16 + l15, qpos = qb * 128 + wv * 16 + l15;
    bf16x8 Qr[4][2];
#pragma unroll
    for (int g = 0; g < 4; ++g)
#pragma unroll
        for (int kk = 0; kk < 2; ++kk) Qr[g][kk] = *(const bf16x8*)(Qb + (size_t)qrow * 1024 + (kvh * 4 + g) * 64 + kk * 32 + quad * 8);
    f32x4 O[4][4]; float mrun[4], lrun[4];
#pragma unroll
    for (int g = 0; g < 4; ++g) { mrun[g] = p.l1_sink[kvh * 4 + g] * 1.44269504089f; lrun[g] = quad == 0 ? 1.f : 0.f;
#pragma unroll
        for (int dt = 0; dt < 4; ++dt) O[g][dt] = (f32x4){0.f, 0.f, 0.f, 0.f}; }
    const int ntile = samp ? 10 : 4;
    const int skey = tid >> 3, shc = (tid & 7) * 8;
    const int skrow = ((skey >> 5) * 2 + ((skey >> 2) & 1)) * 16 + ((skey >> 3) & 3) * 4 + (skey & 3);
    const int vkey = tid & 63, vhc = (tid >> 6) * 8;
#define ATT_TILE_SRC(ti_, kp_, vp_) do { \
        if (samp) { if ((ti_) < 4) { const size_t r0 = (size_t)(b * 256 + (ti_) * 64); kp_ = CK + (r0 + skey) * 256 + kvh * 64 + shc; vp_ = CV + (r0 + vkey) * 256 + kvh * 64 + vhc; } \
                    else { int kp0 = qb * 128 - 128 + ((ti_) - 4) * 64; kp0 = kp0 < 0 ? 0 : (kp0 > 2048 - 64 ? 2048 - 64 : kp0); const size_t r0 = (size_t)(seq0 + kp0); kp_ = Kb + (r0 + skey) * 256 + kvh * 64 + shc; vp_ = Vb + (r0 + vkey) * 256 + kvh * 64 + vhc; } } \
        else { const size_t r0 = (size_t)(seq0 + (ti_) * 64); kp_ = Kb + (r0 + skey) * 256 + kvh * 64 + shc; vp_ = Vb + (r0 + vkey) * 256 + kvh * 64 + vhc; } } while (0)
    u32x4 kq, vq;
    { const bf16_t* kp; const bf16_t* vp; ATT_TILE_SRC(0, kp, vp); kq = *(const u32x4*)kp; vq = *(const u32x4*)vp; }
    for (int ti = 0; ti < ntile; ++ti) {
        const int kpos0 = qb * 128 - 128 + (ti - 4) * 64;
        bool skipw = false, masked = false;
        if (samp && ti >= 4) { const int i0 = qb * 128 + __builtin_amdgcn_readfirstlane(wv) * 16, i1 = i0 + 15;
            skipw = (kpos0 < 0) || (kpos0 >= 2048) || (kpos0 + 63 < i0 - 128) || (kpos0 > i1 + 128);
            masked = !((kpos0 >= i1 - 128) && (kpos0 + 63 <= i0 + 128)); }
        __syncthreads();
        { *(LAS u32x4*)(Ks + skrow * PT + shc) = kq;
          const int key = vkey, hc = vhc;
          VTs[(hc + 0) * PT + key] = (bf16_t)(vq.x & 0xffff); VTs[(hc + 1) * PT + key] = (bf16_t)(vq.x >> 16);
          VTs[(hc + 2) * PT + key] = (bf16_t)(vq.y & 0xffff); VTs[(hc + 3) * PT + key] = (bf16_t)(vq.y >> 16);
          VTs[(hc + 4) * PT + key] = (bf16_t)(vq.z & 0xffff); VTs[(hc + 5) * PT + key] = (bf16_t)(vq.z >> 16);
          VTs[(hc + 6) * PT + key] = (bf16_t)(vq.w & 0xffff); VTs[(hc + 7) * PT + key] = (bf16_t)(vq.w >> 16); }
        __syncthreads();
        if (ti + 1 < ntile) { const bf16_t* kp; const bf16_t* vp; ATT_TILE_SRC(ti + 1, kp, vp); kq = *(const u32x4*)kp; vq = *(const u32x4*)vp; }
        if (!skipw)
#pragma unroll
        for (int g = 0; g < 4; ++g) {
            f32x4 s[4];
#pragma unroll
            for (int kt = 0; kt < 4; ++kt) { s[kt] = (f32x4){0.f, 0.f, 0.f, 0.f};
#pragma unroll
                for (int kk = 0; kk < 2; ++kk) s[kt] = __builtin_amdgcn_mfma_f32_16x16x32_bf16(lds_b8(Ks + (kt * 16 + l15) * PT + kk * 32 + quad * 8), Qr[g][kk], s[kt], 0, 0, 0); }
            if (masked) {
#pragma unroll
                for (int kt = 0; kt < 4; ++kt)
#pragma unroll
                    for (int r = 0; r < 4; ++r) { const int d = qpos - (kpos0 + (kt >> 1) * 32 + quad * 8 + (kt & 1) * 4 + r); if (d > 128 || d < -128) s[kt][r] = -INFINITY; } }
            float mx = fmaxf(fmaxf(fmaxf(s[0][0], s[0][1]), fmaxf(s[0][2], s[0][3])), fmaxf(fmaxf(s[1][0], s[1][1]), fmaxf(s[1][2], s[1][3])));
            mx = fmaxf(mx, fmaxf(fmaxf(fmaxf(s[2][0], s[2][1]), fmaxf(s[2][2], s[2][3])), fmaxf(fmaxf(s[3][0], s[3][1]), fmaxf(s[3][2], s[3][3]))));
            mx = max_x16_x32(mx);
            if (__any(mx > mrun[g] + 4.0f)) {
                const float mn = fmaxf(mrun[g], mx), alpha = __builtin_amdgcn_exp2f(mrun[g] - mn); mrun[g] = mn;
                lrun[g] *= alpha;
#pragma unroll
                for (int dt = 0; dt < 4; ++dt) O[g][dt] *= alpha;
            }
            const float mn = mrun[g];
            float ls = 0.f;
#pragma unroll
            for (int kt = 0; kt < 4; ++kt)
#pragma unroll
                for (int r = 0; r < 4; ++r) { s[kt][r] = __builtin_amdgcn_exp2f(s[kt][r] - mn); ls += s[kt][r]; }
            lrun[g] += ls;
#pragma unroll
            for (int kk = 0; kk < 2; ++kk) {
                u32x4 pw; pw.x = cvt_pk_bf16(s[2 * kk][0], s[2 * kk][1]); pw.y = cvt_pk_bf16(s[2 * kk][2], s[2 * kk][3]); pw.z = cvt_pk_bf16(s[2 * kk + 1][0], s[2 * kk + 1][1]); pw.w = cvt_pk_bf16(s[2 * kk + 1][2], s[2 * kk + 1][3]);
                const bf16x8 pb = __builtin_bit_cast(bf16x8, pw);
#pragma unroll
                for (int dt = 0; dt < 4; ++dt) {
                    O[g][dt] = __builtin_amdgcn_mfma_f32_16x16x32_bf16(lds_b8(VTs + (dt * 16 + l15) * PT + kk * 32 + quad * 8), pb, O[g][dt], 0, 0, 0); } }
            asm volatile("" ::: "memory");
        }
    }
#pragma unroll
    for (int g = 0; g < 4; ++g) { const float l = sum_x16_x32(lrun[g]); const float inv = 1.0f / l;
#pragma unroll
        for (int dt = 0; dt < 4; ++dt) { const f32x4 o = O[g][dt] * inv; u32x2 w; w.x = cvt_pk_bf16(o[0], o[1]); w.y = cvt_pk_bf16(o[2], o[3]);
            *(u32x2*)(Ob + (size_t)qrow * 1024 + (kvh * 4 + g) * 64 + dt * 16 + quad * 4) = w; } }
}

__device__ __forceinline__ void run_up(const Params& p, LAS unsigned char* lds, int li) {
    pg8::GridSrc S; S.init(p.ws + WS_H, 64, p.ws + WS_WUP + (size_t)li * 5632 * 1024 * 2, 64, R_ALL, 5632, gridDim.x, blockIdx.x, 192);
    EpiUp E{(bf16_t*)(p.ws + WS_ACT)};
    pg8::gemm_phase(lds, 64, 64, 1024, S, E, (size_t)R_ALL * 128, (size_t)5632 * 128);
}
__device__ __forceinline__ void run_down(const Params& p, LAS unsigned char* lds, int li, int layer, int gchunk, bool first) {
    pg8::GridSrc S; S.init(p.ws + WS_ACT, 64, p.ws + WS_WDN + (size_t)li * 1024 * 2816 * 2, 64, R_ALL, 1024, gridDim.x, blockIdx.x, 192);
    EpiRes E{p.out, first ? p.x_prompt : nullptr, p.x_sample, (const float*)(p.ws + WS_MOD) + (size_t)layer * 9 * 9216, gchunk, 0.5f};
    pg8::gemm_phase(lds, 64, 64, FF, S, E, (size_t)R_ALL * 128, (size_t)1024 * 128);
}
__device__ __forceinline__ void run_wout(const Params& p, LAS unsigned char* lds, int layer) {
    pg8::GridSrc S; S.init(p.ws + WS_H, 1024, p.ws + (layer ? WS_WL1O : WS_WL0O), 64, R_ALL, 1024, gridDim.x, blockIdx.x, 192);
    EpiRes E{p.out, nullptr, nullptr, (const float*)(p.ws + WS_MOD) + (size_t)layer * 9 * 9216, 5, 1.0f};
    pg8::gemm_phase(lds, 1024, 64, 1024, S, E, 128, (size_t)1024 * 128);
}

__device__ __forceinline__ void run_l0in(const Params& p, LAS unsigned char* lds) {
    const int G = gridDim.x;
    { pg8::GridSrc S; S.init(p.ws + WS_H, 64, p.ws + WS_WL0IN, 64, R_ALL, 1792, G, blockIdx.x, 192);
      EpiL0In E{(bf16_t*)(p.ws + WS_P), (float*)(p.ws + WS_LG)}; pg8::gemm_phase(lds, 64, 64, 1024, S, E, (size_t)R_ALL * 128, (size_t)1792 * 128); }
    { const int c2 = (int)((blockIdx.x + G - (896 % G)) % G);
      pg8::GridSrc S; S.init(p.ws + WS_WL0Z, 64, p.ws + WS_H, 64, 1024, R_ALL, G, c2);
      EpiL0Z E{(bf16_t*)(p.ws + WS_ZTS), (bf16_t*)(p.ws + WS_ZTP)}; pg8::gemm_phase(lds, 64, 64, 1024, S, E, (size_t)1024 * 128, (size_t)R_ALL * 128); }
}
__device__ __forceinline__ void run_l0mix(const Params& p0, LAS unsigned char* lds) {
    const int G = gridDim.x;
    { Params p = p0; { size_t z_ = 0; asm volatile("" : "+s"(z_)); p.ws = p0.ws + z_; p.out = p0.out + z_; }
      for (int w = blockIdx.x; w < 128; w += G) { if (DBG_DFT) dft_unit(p, lds, true, w); } }
    { Params p = p0; { size_t z_ = 0; asm volatile("" : "+s"(z_)); p.ws = p0.ws + z_; p.out = p0.out + z_; }
      for (int w = blockIdx.x; w < 192; w += G) { if (w < 128) continue; gla_unit(p, lds, true, w - 128); } }
    { Params p = p0; { size_t z_ = 0; asm volatile("" : "+s"(z_)); p.ws = p0.ws + z_; p.out = p0.out + z_; }
      for (int w = blockIdx.x; w < 256; w += G) { if (w < 192) continue; if (DBG_DFT) dft_unit(p, lds, false, w - 192); } }
    { Params p = p0; { size_t z_ = 0; asm volatile("" : "+s"(z_)); p.ws = p0.ws + z_; p.out = p0.out + z_; }
      for (int w = blockIdx.x; w < 256; w += G) { if (w < 192) continue; for (int j = 0; j < 4; ++j) gla_unit(p, lds, false, (w - 192) * 4 + j); } }
    { Params p = p0; { size_t z_ = 0; asm volatile("" : "+s"(z_)); p.ws = p0.ws + z_; p.out = p0.out + z_; }
      if (G == 256) { const int b = blockIdx.x; if (b < 128 || b >= 192) { const int rk = b < 128 ? b : b - 64; __syncthreads(); prep_modgemv(p, lds, 144, 288, rk, 192); prep_transposes(p, lds, true, rk, 192); } }
      else { __syncthreads(); prep_modgemv(p, lds, 144, 288, blockIdx.x, G); prep_transposes(p, lds, true, blockIdx.x, G); } }
}
__device__ __forceinline__ void run_qkv(const Params& p, LAS unsigned char* lds) {
    pg8::GridSrc S; S.init(p.ws + WS_H, 64, p.ws + WS_WL1IN, 64, R_ALL, 1536, gridDim.x, blockIdx.x, 192);
    EpiQKV E{(bf16_t*)(p.ws + WS_Q), (bf16_t*)(p.ws + WS_K), (bf16_t*)(p.ws + WS_V), p.out + OUT_KC, p.out + OUT_VC, (const float*)(p.ws + WS_ROPE)};
    pg8::gemm_phase(lds, 64, 64, 1024, S, E, (size_t)R_ALL * 128, (size_t)1536 * 128);
}
__device__ __forceinline__ void run_attn(const Params& p, LAS unsigned char* lds) {
    for (int u = blockIdx.x; u < 768; u += gridDim.x) attn_unit(p, lds, u);
}

__device__ __forceinline__ void phase_dump(const Params& p) {
    const bf16_t* MIX = (const bf16_t*)(p.ws + WS_H); const bf16_t* OB = (const bf16_t*)(p.ws + WS_OB);
    for (size_t i = (size_t)blockIdx.x * NTHR + threadIdx.x; i < (size_t)R_ALL * 1024; i += (size_t)gridDim.x * NTHR) {
        const size_t row = i >> 10; const int c = (int)(i & 1023);
        p.out[i] = c < 512 ? bf2f(MIX[row * 1024 + c]) : bf2f(OB[row * 512 + c - 512]); }
}
#ifndef PH_MASK
#define PH_MASK 0xFFFFFFFFull
#endif
__global__ void __launch_bounds__(NTHR, 2) mega(Params p) {
    extern __shared__ __attribute__((aligned(16))) unsigned char lds_raw[];
    LAS unsigned char* lds = (LAS unsigned char*)lds_raw;
    XcdBarrier xbar; xbar.bar = nullptr; xbar.x = 0; xbar.st = nullptr;
    if (p.coop) {
        volatile LAS unsigned* st = (volatile LAS unsigned*)(lds + LDS_BYTES - 16);
        if (threadIdx.x < 4) st[threadIdx.x] = 0u;
        __syncthreads();
        xbar = xcd_barrier_post((unsigned*)(p.ws + WS_BAR), st);
        if (p.coop == 2) cg::this_grid().sync();
    }
#define SEAM(k) do { if (p.coop && (k) + 1 < p.ph_hi) { xcd_barrier(xbar); } } while (0)
#ifndef DUP_MASK
#define DUP_MASK 0ull
#endif
#ifndef EXTRA_SYNCS
#define EXTRA_SYNCS 0
#endif
#define PHASE(k, body) if (((PH_MASK >> (k)) & 1ull) && p.ph_lo <= (k) && (k) < p.ph_hi) { \
    if ((DUP_MASK >> (k)) & 1ull) { Params q = p; { size_t z_ = 0; asm volatile("" : "+s"(z_)); q.ws = p.ws + z_; q.out = p.out + z_; } body; if (p.coop) xcd_barrier(xbar); } \
    { Params q = p; { size_t z_ = 0; asm volatile("" : "+s"(z_)); q.ws = p.ws + z_; q.out = p.out + z_; } body; } SEAM(k); }
    for (int es = 0; es < EXTRA_SYNCS; ++es) if (p.coop) xcd_barrier(xbar);
    PHASE(0, phase_prep(q, lds))
    PHASE(1, phase_norm(q, q.x_prompt, q.x_sample, q.norm_g + 0, (const float*)(q.ws + WS_MOD), 0))
    PHASE(2, run_up(q, lds, 0))
    PHASE(3, run_down(q, lds, 0, 0, 2, true))
    PHASE(4, phase_norm(q, q.out, q.out + (size_t)R_P * DM, q.norm_g + 1024, (const float*)(q.ws + WS_MOD), 3))
    PHASE(5, run_l0in(q, lds))
    PHASE(6, run_l0mix(q, lds))
    PHASE(7, phase_combine(q))
    PHASE(8, run_wout(q, lds, 0))
    PHASE(9, phase_norm(q, q.out, q.out + (size_t)R_P * DM, q.norm_g + 2048, (const float*)(q.ws + WS_MOD), 6))
    PHASE(10, run_up(q, lds, 1))
    PHASE(11, run_down(q, lds, 1, 0, 8, false))
    PHASE(12, phase_norm(q, q.out, q.out + (size_t)R_P * DM, q.norm_g + 3072, (const float*)(q.ws + WS_MOD) + 9 * 9216, 0))
    PHASE(13, run_up(q, lds, 2))
    PHASE(14, run_down(q, lds, 2, 1, 2, false))
    PHASE(15, phase_norm(q, q.out, q.out + (size_t)R_P * DM, q.norm_g + 3072 + 1024, (const float*)(q.ws + WS_MOD) + 9 * 9216, 3))
    PHASE(16, run_qkv(q, lds))
    PHASE(17, run_attn(q, lds))
    PHASE(18, run_wout(q, lds, 1))
    PHASE(19, phase_norm(q, q.out, q.out + (size_t)R_P * DM, q.norm_g + 3072 + 2048, (const float*)(q.ws + WS_MOD) + 9 * 9216, 6))
    PHASE(20, run_up(q, lds, 3))
    PHASE(21, run_down(q, lds, 3, 1, 8, false))
    PHASE(22, phase_final_norm(q))
    PHASE(23, phase_dump(q))
#undef PHASE
#undef SEAM
}

constexpr int N_PHASES = 23;
constexpr int RUN_PHASES = N_PHASES;
#ifndef ONE_LAUNCH
#define ONE_LAUNCH 1
#endif

extern "C" void kernel_launch(void* const* d_in, const int* in_sizes, int n_in, void* d_out, int out_size, void* d_ws, size_t ws_size, hipStream_t stream) {
    static int grid = 0;
    if (grid == 0) {
        if (n_in != 25 || ws_size < WS_END) { fprintf(stderr, "kernel_launch: unexpected n_in %d or ws_size %zu (need %zu)\n", n_in, ws_size, (size_t)WS_END); grid = -1; return; }
        int dev = 0, cus = 0, per_cu = 0;
        hipGetDevice(&dev); hipDeviceGetAttribute(&cus, hipDeviceAttributeMultiprocessorCount, dev);
        if (hipFuncSetAttribute((const void*)mega, hipFuncAttributeMaxDynamicSharedMemorySize, LDS_BYTES) != hipSuccess) { fprintf(stderr, "kernel_launch: hipFuncSetAttribute failed\n"); grid = -1; return; }
        hipOccupancyMaxActiveBlocksPerMultiprocessor(&per_cu, (const void*)mega, NTHR, LDS_BYTES);
        (void)hipGetLastError();
        if (per_cu < 1) per_cu = 1;
        if (per_cu > 1) per_cu = 1;
        grid = cus * per_cu;
    }
    if (grid < 0) return;
    Params p{};
    p.x_prompt = (const float*)d_in[0]; p.x_sample = (const float*)d_in[1]; p.st_f = (const float*)d_in[2]; p.st_b = (const float*)d_in[3];
    p.cache_k = (const float*)d_in[4]; p.cache_v = (const float*)d_in[5]; p.c = (const float*)d_in[6]; p.c_ctx = (const float*)d_in[7];
    p.mod_w = (const float*)d_in[8]; p.mod_b = (const float*)d_in[9]; p.norm_g = (const float*)d_in[10];
    p.ffn_w1 = (const float*)d_in[11]; p.ffn_w3 = (const float*)d_in[12]; p.ffn_w2 = (const float*)d_in[13];
    p.l0_w_in = (const float*)d_in[14]; p.l0_w_gf = (const float*)d_in[15]; p.l0_b_gf = (const float*)d_in[16]; p.l0_w_gb = (const float*)d_in[17]; p.l0_b_gb = (const float*)d_in[18];
    p.l0_g_head = (const float*)d_in[19]; p.l0_w_out = (const float*)d_in[20]; p.l1_w_in = (const float*)d_in[21]; p.l1_sink = (const float*)d_in[22]; p.l1_w_out = (const float*)d_in[23];
    p.final_g = (const float*)d_in[24];
    p.out = (float*)d_out; p.ws = (unsigned char*)d_ws;
#if ONE_LAUNCH
    if (hipMemsetAsync((char*)d_ws + WS_MOD, 0, WS_BAR + 16384 - WS_MOD, stream) != hipSuccess) { fprintf(stderr, "kernel_launch: memset failed\n"); return; }
    p.ph_lo = 0; p.ph_hi = N_PHASES; p.coop = 1; p.pad = 0;
    void* args[] = {&p};
    hipError_t e = hipLaunchCooperativeKernel((const void*)mega, dim3(grid), dim3(NTHR), args, LDS_BYTES, stream);
    if (e != hipSuccess) fprintf(stderr, "cooperative launch failed: %s (grid %d)\n", hipGetErrorString(e), grid);
#else
    for (int ph = 0; ph < RUN_PHASES; ++ph) {
        p.ph_lo = ph; p.ph_hi = ph + 1; p.coop = 0; p.pad = 0;
        hipLaunchKernelGGL(mega, dim3(grid), dim3(NTHR), LDS_BYTES, stream, p);
    }
#endif
}
```
